# Optimizing an MI355X kernel written in HIP

```python
import jax
import jax.numpy as jnp
from jax import lax
import numpy as np

D_MODEL = 1024
BATCH = 8
SEQ = 8192
DEPTH = 1

CHUNK = 64
Q_BLOCK = 128
HEAD_DIM = 64
FOX_HEADS = 8
DSA_HEADS = 8
IDX_HEADS = 8
IDX_DIM = 32
TOPK_MAX = 256
ROPE_THETA = 500000.0
ROPE_FRACTION = 4
D_FF = 2816
N_SUBLAYERS = 3
NORM_EPS = 1e-6
FOX_WIDTH = FOX_HEADS * HEAD_DIM
DSA_WIDTH = DSA_HEADS * HEAD_DIM
IN_SIZES = (FOX_WIDTH, FOX_WIDTH, FOX_WIDTH, FOX_HEADS, DSA_WIDTH, HEAD_DIM, HEAD_DIM, IDX_HEADS * IDX_DIM, IDX_DIM, IDX_HEADS, D_MODEL, D_MODEL)
D_IN = sum(IN_SIZES)

kernel_name = 'hybrid_fox_dsa_macaron_block'


def rms_norm(x, g):
    xf = x.astype(jnp.float32)
    y = xf * lax.rsqrt(jnp.mean(xf * xf, axis=-1, keepdims=True) + NORM_EPS)
    return (y * g.astype(jnp.float32)).astype(x.dtype)


def modulate(x, g, shift, scale):
    return rms_norm(x, g) * (1 + scale[:, None, :]) + shift[:, None, :]


def swiglu(h, w1, w3, w2):
    return (jax.nn.silu(h @ w1) * (h @ w3)) @ w2


def rope_tables(positions, rot_dim):
    inv_freq = ROPE_THETA ** (-jnp.arange(0, rot_dim, 2, dtype=jnp.float32) / rot_dim)
    ang = positions.astype(jnp.float32)[..., None] * inv_freq
    return jnp.cos(ang), jnp.sin(ang)


def partial_rope(x, cos, sin):
    half = cos.shape[-1]
    x1 = x[..., :half].astype(jnp.float32)
    x2 = x[..., half:2 * half].astype(jnp.float32)
    r1 = (x1 * cos - x2 * sin).astype(x.dtype)
    r2 = (x2 * cos + x1 * sin).astype(x.dtype)
    return jnp.concatenate([r1, r2, x[..., 2 * half:]], axis=-1)


def fox_attention(q, k, v, log_f):
    B, S, H, dh = q.shape
    F = jnp.cumsum(log_f.astype(jnp.float32), axis=1).transpose(0, 2, 1)
    kpos = jnp.arange(S)
    scale = dh ** -0.5

    def block(i):
        qs = i * Q_BLOCK
        qb = lax.dynamic_slice_in_dim(q, qs, Q_BLOCK, axis=1)
        Fq = lax.dynamic_slice_in_dim(F, qs, Q_BLOCK, axis=2)
        s = jnp.einsum('bqhd,bkhd->bhqk', qb, k, preferred_element_type=jnp.float32) * scale
        s = s + Fq[..., None] - F[:, :, None, :]
        qpos = qs + jnp.arange(Q_BLOCK)
        mask = kpos[None, :] <= qpos[:, None]
        s = jnp.where(mask[None, None], s, -jnp.inf)
        p = jax.nn.softmax(s, axis=-1)
        return jnp.einsum('bhqk,bkhd->bqhd', p.astype(v.dtype), v)

    out = lax.map(block, jnp.arange(S // Q_BLOCK))
    return out.transpose(1, 0, 2, 3, 4).reshape(B, S, H, dh)


def dsa_attention(q, k, v, iq, ik, iw, top_k):
    B, S, H, dh = q.shape
    kchunk = jnp.arange(S) // CHUNK
    scale = dh ** -0.5
    idx_scale = IDX_DIM ** -0.5

    def block(i):
        qs = i * Q_BLOCK
        qb = lax.dynamic_slice_in_dim(q, qs, Q_BLOCK, axis=1)
        iqb = lax.dynamic_slice_in_dim(iq, qs, Q_BLOCK, axis=1)
        iwb = lax.dynamic_slice_in_dim(iw, qs, Q_BLOCK, axis=1)
        qchunk = (qs + jnp.arange(Q_BLOCK)) // CHUNK
        admissible = kchunk[None, :] <= qchunk[:, None]
        dots = jnp.einsum('bqhd,bkd->bqhk', iqb, ik, preferred_element_type=jnp.float32) * idx_scale
        score = jnp.einsum('bqh,bqhk->bqk', iwb.astype(jnp.float32), jax.nn.relu(dots))
        score = jnp.where(admissible[None], score, -jnp.inf)
        _, sel = lax.top_k(score, top_k)
        kg = jax.vmap(lambda kb, ib: kb[ib])(k, sel)
        vg = jax.vmap(lambda vb, ib: vb[ib])(v, sel)
        valid = (sel // CHUNK) <= qchunk[None, :, None]
        s = jnp.einsum('bqhd,bqkd->bhqk', qb, kg, preferred_element_type=jnp.float32) * scale
        s = jnp.where(valid[:, None], s, -jnp.inf)
        p = jax.nn.softmax(s, axis=-1)
        return jnp.einsum('bhqk,bqkd->bqhd', p.astype(vg.dtype), vg)

    out = lax.map(block, jnp.arange(S // Q_BLOCK))
    return out.transpose(1, 0, 2, 3, 4).reshape(B, S, H, dh)


def hybrid_mixer(h, w_in, fox_f_bias, fox_qk_g, dsa_qk_g, w_br_fox, w_br_dsa, w_out, rope_a, rope_i, top_k):
    B, S, _ = h.shape
    cos_a, sin_a = rope_a
    cos_i, sin_i = rope_i
    z = h @ w_in
    split_points = [int(p) for p in np.cumsum(IN_SIZES)[:-1]]
    (fq, fk, fv, ff, dq, dk, dv, iq, ik, iw, ga, gb) = jnp.split(z, split_points, axis=-1)
    fq = rms_norm(fq.reshape(B, S, FOX_HEADS, HEAD_DIM), fox_qk_g[0])
    fk = rms_norm(fk.reshape(B, S, FOX_HEADS, HEAD_DIM), fox_qk_g[1])
    fv = fv.reshape(B, S, FOX_HEADS, HEAD_DIM)
    log_f = jax.nn.log_sigmoid(ff.astype(jnp.float32) + fox_f_bias.astype(jnp.float32))
    ya = fox_attention(fq, fk, fv, log_f).reshape(B, S, FOX_WIDTH)
    dq = partial_rope(rms_norm(dq.reshape(B, S, DSA_HEADS, HEAD_DIM), dsa_qk_g[0]), cos_a[:, :, None, :], sin_a[:, :, None, :])
    dk = partial_rope(rms_norm(dk, dsa_qk_g[1]), cos_a, sin_a)
    iq = partial_rope(iq.reshape(B, S, IDX_HEADS, IDX_DIM), cos_i[:, :, None, :], sin_i[:, :, None, :])
    ik = partial_rope(ik, cos_i, sin_i)
    iw = iw * (IDX_HEADS ** -0.5)
    yb = dsa_attention(dq, dk, dv, iq, ik, iw, top_k).reshape(B, S, DSA_WIDTH)
    merged = jax.nn.sigmoid(ga) * (ya @ w_br_fox) + jax.nn.sigmoid(gb) * (yb @ w_br_dsa)
    return merged @ w_out


def setup_inputs(seed: int = 0) -> dict:
    key = jax.random.key(seed)
    ks = jax.random.split(key, 24)
    L = DEPTH

    def nrm(k, shape, fan_in, gain=1.0):
        return jax.random.normal(k, shape, jnp.float32) * (gain * fan_in ** -0.5)

    x = jax.random.normal(ks[0], (BATCH, SEQ, D_MODEL), jnp.float32)
    c = jax.random.normal(ks[1], (BATCH, D_MODEL), jnp.float32)
    offsets = jax.random.randint(ks[2], (BATCH, 1), 0, 1024) * CHUNK
    positions = (offsets + jnp.arange(SEQ, dtype=jnp.int32)[None, :]).astype(jnp.int32)
    ada_w = nrm(ks[3], (L, D_MODEL, 3 * N_SUBLAYERS * D_MODEL), D_MODEL, 0.5)
    ada_b = 0.02 * jax.random.normal(ks[4], (L, 3 * N_SUBLAYERS * D_MODEL), jnp.float32)
    norm_g = 1.0 + 0.05 * jax.random.normal(ks[5], (L, N_SUBLAYERS, D_MODEL), jnp.float32)
    ffn1_w1 = nrm(ks[6], (L, D_MODEL, D_FF), D_MODEL)
    ffn1_w3 = nrm(ks[7], (L, D_MODEL, D_FF), D_MODEL)
    ffn1_w2 = nrm(ks[8], (L, D_FF, D_MODEL), D_FF)
    w_in = nrm(ks[9], (L, D_MODEL, D_IN), D_MODEL)
    fox_f_bias = 2.0 + 0.1 * jax.random.normal(ks[10], (L, FOX_HEADS), jnp.float32)
    fox_qk_g = 1.0 + 0.05 * jax.random.normal(ks[11], (L, 2, HEAD_DIM), jnp.float32)
    dsa_qk_g = 1.0 + 0.05 * jax.random.normal(ks[12], (L, 2, HEAD_DIM), jnp.float32)
    w_br_fox = nrm(ks[13], (L, FOX_WIDTH, D_MODEL), FOX_WIDTH)
    w_br_dsa = nrm(ks[14], (L, DSA_WIDTH, D_MODEL), DSA_WIDTH)
    w_out = nrm(ks[15], (L, D_MODEL, D_MODEL), D_MODEL)
    ffn2_w1 = nrm(ks[16], (L, D_MODEL, D_FF), D_MODEL)
    ffn2_w3 = nrm(ks[17], (L, D_MODEL, D_FF), D_MODEL)
    ffn2_w2 = nrm(ks[18], (L, D_FF, D_MODEL), D_FF)
    return {'x': x, 'c': c, 'positions': positions, 'ada_w': ada_w, 'ada_b': ada_b,
            'norm_g': norm_g, 'ffn1_w1': ffn1_w1, 'ffn1_w3': ffn1_w3, 'ffn1_w2': ffn1_w2,
            'w_in': w_in, 'fox_f_bias': fox_f_bias, 'fox_qk_g': fox_qk_g, 'dsa_qk_g': dsa_qk_g,
            'w_br_fox': w_br_fox, 'w_br_dsa': w_br_dsa, 'w_out': w_out,
            'ffn2_w1': ffn2_w1, 'ffn2_w3': ffn2_w3, 'ffn2_w2': ffn2_w2}


def reference(x, c, positions, ada_w, ada_b, norm_g, ffn1_w1, ffn1_w3, ffn1_w2, w_in, fox_f_bias, fox_qk_g, dsa_qk_g, w_br_fox, w_br_dsa, w_out, ffn2_w1, ffn2_w3, ffn2_w2):
    B, S, _ = x.shape
    top_k = min(TOPK_MAX, S // 4)
    rope_a = rope_tables(positions, HEAD_DIM // ROPE_FRACTION)
    rope_i = rope_tables(positions, IDX_DIM // ROPE_FRACTION)
    cond = jax.nn.silu(c)
    for l in range(DEPTH):
        mod = (cond @ ada_w[l] + ada_b[l]).reshape(B, N_SUBLAYERS, 3, D_MODEL)
        h = modulate(x, norm_g[l, 0], mod[:, 0, 0], mod[:, 0, 1])
        x = x + 0.5 * mod[:, 0, 2][:, None, :] * swiglu(h, ffn1_w1[l], ffn1_w3[l], ffn1_w2[l])
        h = modulate(x, norm_g[l, 1], mod[:, 1, 0], mod[:, 1, 1])
        y = hybrid_mixer(h, w_in[l], fox_f_bias[l], fox_qk_g[l], dsa_qk_g[l], w_br_fox[l], w_br_dsa[l], w_out[l], rope_a, rope_i, top_k)
        x = x + mod[:, 1, 2][:, None, :] * y
        h = modulate(x, norm_g[l, 2], mod[:, 2, 0], mod[:, 2, 1])
        x = x + 0.5 * mod[:, 2, 2][:, None, :] * swiglu(h, ffn2_w1[l], ffn2_w3[l], ffn2_w2[l])
    return x
```

```cpp
#include <hip/hip_runtime.h>
#include <hip/hip_cooperative_groups.h>
#include <cstdio>
#include <cstdint>
#include <cmath>
namespace cg = cooperative_groups;
namespace pg8 {
#define PG8_LAS __attribute__((address_space(3)))
typedef unsigned short bf16_t;
typedef short bf16x8 __attribute__((ext_vector_type(8)));
typedef float f32x4 __attribute__((ext_vector_type(4)));
typedef unsigned u32x4 __attribute__((ext_vector_type(4)));
constexpr int BM = 256, BK = 64, HALF = 128, HTB = HALF * BK * 2  , STAGE_BYTES = 8 * HTB, NXCD = 8, WGM = 8;

__host__ __device__ __forceinline__ int lds_byte(int r, int c) { const int st = (r >> 4) * 2 + (c >> 5), rr = r & 15, cc = c & 31, ob = rr * 64 + cc * 2; return st * 1024 + (ob ^ (((ob >> 9) & 1) << 5)); }
__host__ __device__ __forceinline__ void stage_rc(int b, int& R, int& C) { const int st = b / 1024, sb = b % 1024, swz = sb ^ (((sb >> 9) & 1) << 5); R = (st >> 1) * 16 + swz / 64; C = (st & 1) * 32 + (swz % 64) / 2; }
__host__ __device__ __forceinline__ int perm32(int rho) { const int n = rho >> 4, i = rho & 15; return 8 * (i >> 2) + 4 * n + (i & 3); }

struct Unit { int pm, pn; };
struct Gemm { const bf16_t* A; const bf16_t* Bt; int M, N, K; };

struct StaticOrder {
    int nM, nN, nwg, G, c;
    __host__ __device__ void init(int M, int N, int G_, int c_) { nM = M / BM; nN = N / BM; nwg = nM * nN; G = G_; c = c_; }
    __host__ __device__ bool next(int i, Unit& u) const {
        const long L = (long)i * G + c; if (L >= nwg) return false;
        int wgid = (int)L; { const int q = nwg / NXCD, r = nwg % NXCD, xcd = wgid % NXCD, off = wgid / NXCD; wgid = (xcd < r ? xcd * (q + 1) : r * (q + 1) + (xcd - r) * q) + off; }
        const int nig = WGM * nN, gid = wgid / nig, fm = gid * WGM, gsz = (nM - fm) < WGM ? (nM - fm) : WGM;
        u.pm = fm + ((wgid % nig) % gsz); u.pn = (wgid % nig) / gsz; return true;
    }
    __device__ __forceinline__ void a_ready(const Unit&) const {}
    __device__ __forceinline__ void done(const Unit&) const {}
};

__device__ __forceinline__ unsigned cvt_pk_bf16(float lo, float hi) { unsigned r; asm volatile("v_cvt_pk_bf16_f32 %0, %1, %2" : "=v"(r) : "v"(lo), "v"(hi)); return r; }
typedef float f32x2 __attribute__((ext_vector_type(2)));
__device__ __forceinline__ f32x2 gelu_pk(f32x2 v) {
    const f32x2 av = __builtin_elementwise_abs(v), d = av * 0.2316418882f + 1.0f;
    f32x2 t; t.x = __builtin_amdgcn_rcpf(d.x); t.y = __builtin_amdgcn_rcpf(d.y);
    f32x2 q = t * 0.5307027145f + (-0.7265760135f); q = q * t + 0.7107068705f; q = q * t + (-0.142248368f); q = q * t + 0.127414796f; q = q * t;
    const f32x2 s = (v * v) * (-0.72134752044f);
    f32x2 e; e.x = __builtin_amdgcn_exp2f(s.x); e.y = __builtin_amdgcn_exp2f(s.y);
    const f32x2 m = v * (q * e), r = v - m;
    f32x2 o; o.x = v.x < 0.f ? m.x : r.x; o.y = v.y < 0.f ? m.y : r.y; return o;
}

template <int ACT  > struct EpiBf16 {
    static constexpr bool PERM = true, AFTER_DRAIN = false; static_assert(ACT == 0 || ACT == 1, "EpiBf16: ACT is 0 (none) or 1 (gelu_pk)");
    bf16_t* O; int ldc; const float* bias; int split_cols; size_t split_stride; float scale0;
    __device__ __forceinline__ void operator()(const f32x4 (&acc)[2][2][4][2], const Unit& u, int wr, int wc, int fr, int fq) const {
        const int row0 = u.pm * BM + wr * 64 + fr; int colt = u.pn * BM; bf16_t* base = O;
        float sc = 1.f; if (split_cols) { const int t = colt / split_cols; base += (size_t)t * split_stride; colt -= t * split_cols; if (t == 0) sc = scale0; }
        const int col0 = colt + wc * 32 + 8 * fq, bcol0 = u.pn * BM + wc * 32 + 8 * fq;
        f32x4 bv[2][2];
#pragma unroll
        for (int bj = 0; bj < 2; ++bj)
#pragma unroll
            for (int n = 0; n < 2; ++n) bv[bj][n] = bias ? *(const f32x4*)(bias + bcol0 + bj * HALF + 4 * n) : (f32x4){0.f, 0.f, 0.f, 0.f};
#pragma unroll
        for (int ai = 0; ai < 2; ++ai)
#pragma unroll
            for (int m = 0; m < 4; ++m) { bf16_t* rowp = base + (size_t)(row0 + ai * HALF + m * 16) * ldc + col0;
#pragma unroll
                for (int bj = 0; bj < 2; ++bj) { f32x4 v0 = acc[ai][bj][m][0] + bv[bj][0], v1 = acc[ai][bj][m][1] + bv[bj][1];
                    if (ACT == 1) { f32x2 a = gelu_pk((f32x2){v0[0], v0[1]}), b = gelu_pk((f32x2){v0[2], v0[3]}), c = gelu_pk((f32x2){v1[0], v1[1]}), d = gelu_pk((f32x2){v1[2], v1[3]});
                        v0 = (f32x4){a.x, a.y, b.x, b.y}; v1 = (f32x4){c.x, c.y, d.x, d.y}; }
                    v0 = v0 * sc; v1 = v1 * sc; u32x4 w; w.x = cvt_pk_bf16(v0[0], v0[1]); w.y = cvt_pk_bf16(v0[2], v0[3]); w.z = cvt_pk_bf16(v1[0], v1[1]); w.w = cvt_pk_bf16(v1[2], v1[3]);
                    *(u32x4*)(rowp + bj * HALF) = w; } }
    }
};
template <class Epi, class Sched, bool ALIGN_EPI = false, bool SP2 = false>
__device__ __forceinline__ void gemm_phase(PG8_LAS unsigned char* lds, const Gemm g, const Sched& S, const Epi& E) {
    const int tid = threadIdx.x, wid = __builtin_amdgcn_readfirstlane(tid >> 6), lane = tid & 63, wr = wid >> 2, wc = wid & 3, fr = lane & 15, fq = lane >> 4;
    const int K = g.K, nt = K / BK;
    unsigned voffA[2], voffB[2];
#pragma unroll
    for (int i = 0; i < 2; ++i) { int R, C; stage_rc(tid * 16 + i * 8192, R, C); const int Rb = Epi::PERM ? ((R & ~31) + perm32(R & 31)) : R;
        voffA[i] = (unsigned)(R * K + C) * 2u; voffB[i] = (unsigned)(Rb * K + C) * 2u; }
    const size_t kstep = (size_t)(BK * 2);
    const size_t hstep = (size_t)HALF * K * 2;
    const size_t tstep = 2 * hstep;
    const unsigned ldsw = (unsigned)wid * 1024u;
    const int aoff = lds_byte(wr * 64 + fr, fq * 8), boff = lds_byte(wc * 32 + fr, fq * 8);
#define PG8_SA(b, h) (((b) * 2 + (h)) * HTB)
#define PG8_SB(b, h) ((4 + (b) * 2 + (h)) * HTB)
#define PG8_STAGE(bufoff, gbase, voff) do { _Pragma("unroll") for (int _i = 0; _i < 2; ++_i) \
        __builtin_amdgcn_global_load_lds((const unsigned*)((const char*)(gbase) + (voff)[_i]), (PG8_LAS unsigned*)(lds + (bufoff) + ldsw + _i * 8192), 16, 0, 0); } while (0)
#define PG8_LDA(dst, b, h) do { _Pragma("unroll") for (int m = 0; m < 4; ++m) _Pragma("unroll") for (int k = 0; k < 2; ++k) dst[m][k] = *(const PG8_LAS bf16x8*)(lds + PG8_SA(b, h) + aoff + m * 2048 + k * 1024); } while (0)
#define PG8_LDB(dst, b, h) do { _Pragma("unroll") for (int n = 0; n < 2; ++n) _Pragma("unroll") for (int k = 0; k < 2; ++k) dst[n][k] = *(const PG8_LAS bf16x8*)(lds + PG8_SB(b, h) + boff + n * 2048 + k * 1024); } while (0)
#define PG8_MMA(ai, bj, At, Bt) do { __builtin_amdgcn_s_setprio(1); _Pragma("unroll") for (int m = 0; m < 4; ++m) _Pragma("unroll") for (int n = 0; n < 2; ++n) _Pragma("unroll") for (int k = 0; k < 2; ++k) \
        acc[ai][bj][m][n] = __builtin_amdgcn_mfma_f32_16x16x32_bf16(Bt[n][k], At[m][k], acc[ai][bj][m][n], 0, 0, 0); __builtin_amdgcn_s_setprio(0); } while (0)
#define PG8_WAIT_V(n) asm volatile("s_waitcnt vmcnt(" #n ")" ::: "memory")
#define PG8_WAIT_L(n) asm volatile("s_waitcnt lgkmcnt(" #n ")" ::: "memory")
#define PG8_BAR __builtin_amdgcn_s_barrier()
#define PG8_SCHED __builtin_amdgcn_sched_barrier(0)
    Unit cur, nxt; int ui = 0;
    if (!S.next(0, cur)) return;
    f32x4 acc[2][2][4][2];
#pragma unroll
    for (int a = 0; a < 2; ++a)
#pragma unroll
        for (int b = 0; b < 2; ++b)
#pragma unroll
            for (int m = 0; m < 4; ++m)
#pragma unroll
                for (int n = 0; n < 2; ++n) acc[a][b][m][n] = (f32x4){0.f, 0.f, 0.f, 0.f};
    bf16x8 At[4][2], B0[2][2], B1[2][2];
    const char* cA = (const char*)g.A + (size_t)cur.pm * tstep; const char* cB = (const char*)g.Bt + (size_t)cur.pn * tstep;
    S.a_ready(cur);
    if constexpr (SP2) {
        PG8_STAGE(PG8_SB(0, 0), cB, voffB); PG8_STAGE(PG8_SB(0, 1), cB + hstep, voffB); PG8_STAGE(PG8_SA(0, 0), cA, voffA); PG8_STAGE(PG8_SA(0, 1), cA + hstep, voffA);
        if (wr == 1) PG8_BAR;
        PG8_WAIT_V(2); PG8_BAR;
        PG8_STAGE(PG8_SB(1, 0), cB + kstep, voffB); PG8_STAGE(PG8_SA(1, 0), cA + kstep, voffA); PG8_STAGE(PG8_SB(1, 1), cB + hstep + kstep, voffB);
        PG8_WAIT_V(6); PG8_BAR;
    } else {
        PG8_STAGE(PG8_SB(0, 0), cB, voffB); PG8_STAGE(PG8_SA(0, 0), cA, voffA); PG8_STAGE(PG8_SB(0, 1), cB + hstep, voffB); PG8_STAGE(PG8_SA(0, 1), cA + hstep, voffA);
        if (wr == 1) PG8_BAR;
        PG8_WAIT_V(4); PG8_BAR;
        PG8_STAGE(PG8_SB(1, 0), cB + kstep, voffB); PG8_STAGE(PG8_SA(1, 0), cA + kstep, voffA); PG8_STAGE(PG8_SB(1, 1), cB + hstep + kstep, voffB);
        PG8_WAIT_V(6); PG8_BAR;
    }
    for (;;) {
        const bool has_next = S.next(ui + 1, nxt);
        const char* nA = has_next ? (const char*)g.A + (size_t)nxt.pm * tstep : cA; const char* nB = has_next ? (const char*)g.Bt + (size_t)nxt.pn * tstep : cB;
        for (int t = 0; t < nt; t += 2) {
            const bool last = (t == nt - 2);
            const char* a1 = cA + (size_t)(t + 1) * kstep;
            const char* a2 = last ? nA : cA + (size_t)(t + 2) * kstep; const char* b2 = last ? nB : cB + (size_t)(t + 2) * kstep;
            const char* a3 = a2 + kstep; const char* b3 = b2 + kstep;
            if (last && has_next) S.a_ready(nxt);
            if constexpr (SP2) {
            PG8_LDB(B0, 0, 0); PG8_LDB(B1, 0, 1); PG8_SCHED; PG8_LDA(At, 0, 0); PG8_STAGE(PG8_SA(1, 1), a1 + hstep, voffA);
            PG8_WAIT_V(8); PG8_WAIT_L(0); PG8_BAR; PG8_MMA(0, 0, At, B0); PG8_MMA(0, 1, At, B1); PG8_BAR; PG8_SCHED;
            PG8_LDA(At, 0, 1); PG8_STAGE(PG8_SB(0, 0), b2, voffB); PG8_STAGE(PG8_SB(0, 1), b2 + hstep, voffB); PG8_STAGE(PG8_SA(0, 0), a2, voffA);
            PG8_WAIT_V(8); PG8_WAIT_L(0); PG8_BAR; PG8_MMA(1, 0, At, B0); PG8_MMA(1, 1, At, B1); PG8_BAR; PG8_SCHED;
            PG8_LDB(B0, 1, 0); PG8_LDB(B1, 1, 1); PG8_SCHED; PG8_LDA(At, 1, 0); PG8_STAGE(PG8_SA(0, 1), a2 + hstep, voffA);
            PG8_WAIT_V(8); PG8_WAIT_L(0); PG8_BAR; PG8_MMA(0, 0, At, B0); PG8_MMA(0, 1, At, B1); PG8_BAR; PG8_SCHED;
            PG8_LDA(At, 1, 1); PG8_STAGE(PG8_SB(1, 0), b3, voffB); PG8_STAGE(PG8_SB(1, 1), b3 + hstep, voffB); PG8_STAGE(PG8_SA(1, 0), a3, voffA);
            PG8_WAIT_V(8); PG8_WAIT_L(0); PG8_BAR; PG8_MMA(1, 0, At, B0); PG8_MMA(1, 1, At, B1); PG8_BAR; PG8_SCHED;
            } else {
            PG8_LDB(B0, 0, 0); PG8_SCHED; PG8_LDA(At, 0, 0); PG8_STAGE(PG8_SA(1, 1), a1 + hstep, voffA);
            PG8_WAIT_L(8); PG8_BAR; PG8_WAIT_L(0); PG8_MMA(0, 0, At, B0); PG8_BAR; PG8_SCHED;
            PG8_LDB(B1, 0, 1); PG8_STAGE(PG8_SB(0, 0), b2, voffB);
            PG8_BAR; PG8_WAIT_L(0); PG8_MMA(0, 1, At, B1); PG8_BAR;
            PG8_LDA(At, 0, 1); PG8_STAGE(PG8_SA(0, 0), a2, voffA);
            PG8_BAR; PG8_WAIT_L(0); PG8_MMA(1, 0, At, B0); PG8_BAR; PG8_SCHED;
            PG8_STAGE(PG8_SB(0, 1), b2 + hstep, voffB);
            PG8_WAIT_V(6); PG8_BAR; PG8_MMA(1, 1, At, B1); PG8_BAR;
            PG8_LDB(B0, 1, 0); PG8_SCHED; PG8_LDA(At, 1, 0); PG8_STAGE(PG8_SA(0, 1), a2 + hstep, voffA);
            PG8_WAIT_L(8); PG8_BAR; PG8_WAIT_L(0); PG8_MMA(0, 0, At, B0); PG8_BAR; PG8_SCHED;
            PG8_LDB(B1, 1, 1); PG8_STAGE(PG8_SB(1, 0), b3, voffB);
            PG8_BAR; PG8_WAIT_L(0); PG8_MMA(0, 1, At, B1); PG8_BAR;
            PG8_LDA(At, 1, 1); PG8_STAGE(PG8_SA(1, 0), a3, voffA);
            PG8_BAR; PG8_WAIT_L(0); PG8_MMA(1, 0, At, B0); PG8_BAR; PG8_SCHED;
            PG8_STAGE(PG8_SB(1, 1), b3 + hstep, voffB);
            PG8_WAIT_V(6); PG8_BAR; PG8_MMA(1, 1, At, B1); PG8_BAR;
            }
        }
        if constexpr (ALIGN_EPI) { if (wr == 0) PG8_BAR; }
        if constexpr (!Epi::AFTER_DRAIN) { E(acc, cur, wr, wc, fr, fq); S.done(cur); }
        if (!has_next) break;
#pragma unroll
        for (int a = 0; a < 2; ++a)
#pragma unroll
            for (int b = 0; b < 2; ++b)
#pragma unroll
                for (int m = 0; m < 4; ++m)
#pragma unroll
                    for (int n = 0; n < 2; ++n) acc[a][b][m][n] = (f32x4){0.f, 0.f, 0.f, 0.f};
        cur = nxt; cA = nA; cB = nB; ++ui;
        if constexpr (ALIGN_EPI) { if (wr == 1) PG8_BAR; }
    }
    PG8_WAIT_V(0);
    if constexpr (!ALIGN_EPI) { if (wr == 0) PG8_BAR; }
    PG8_BAR;
    if constexpr (Epi::AFTER_DRAIN) { E.fused(acc, cur, wr, wc, fr, fq, lds, wid, lane); S.done(cur); }
#undef PG8_SA
#undef PG8_SB
#undef PG8_STAGE
#undef PG8_LDA
#undef PG8_LDB
#undef PG8_MMA
#undef PG8_WAIT_V
#undef PG8_WAIT_L
#undef PG8_BAR
#undef PG8_SCHED
}
}

#define LAS __attribute__((address_space(3)))
typedef unsigned short bf16_t;
typedef short bf16x8 __attribute__((ext_vector_type(8)));
typedef float f32x4 __attribute__((ext_vector_type(4)));
typedef float f32x16 __attribute__((ext_vector_type(16)));
typedef unsigned u32x4 __attribute__((ext_vector_type(4)));
typedef unsigned u32x2 __attribute__((ext_vector_type(2)));
typedef short s16x4 __attribute__((ext_vector_type(4)));

constexpr int NB = 8, SEQ = 8192, DM = 1024, MT = NB * SEQ, FF = 2816, NZ = 4608, NUP = 2 * FF, NMOD = 9216;
constexpr int ZQ = 0, ZK = 512, ZV = 1024, ZDQ = 1536, ZDK = 2048, ZDV = 2112, ZIQ = 2176, ZIK = 2432, ZFF = 2464, ZIW = 2472, ZGA = 2560, ZGB = 3584;
constexpr float LOG2E = 1.4426950408889634f;
constexpr float C2 = 0.125f * LOG2E;
constexpr size_t MiB = 1u << 20;
constexpr size_t WS_MOD = 1 * MiB, WS_SIDE = 2 * MiB, WS_F2 = 6 * MiB, WS_LF = 8 * MiB, WS_WQ = 10 * MiB;
constexpr size_t WS_WUP1 = 12 * MiB, WS_WDN1 = 24 * MiB, WS_WUP2 = 30 * MiB, WS_WDN2 = 42 * MiB, WS_WIN = 48 * MiB, WS_WA = 58 * MiB, WS_WB = 59 * MiB, WS_WO = 60 * MiB;
constexpr size_t WS_HN = 64 * MiB, WS_Y = 192 * MiB, WS_Z = 320 * MiB, WS_END = 896 * MiB;
constexpr int LDS_BYTES = 147456;

struct Params {
    const float *x, *c; const int* pos; const float *ada_w, *ada_b, *norm_g, *f1w1, *f1w3, *f1w2, *w_in, *fbias, *fox_g, *dsa_g, *wbf, *wbd, *wout, *f2w1, *f2w3, *f2w2;
    float* out; unsigned char* ws;
    float invfA[8]; float invfI[4];
    int ph_lo, ph_hi;
};

__device__ __forceinline__ int rfl(int v) { return __builtin_amdgcn_readfirstlane(v); }
__device__ __forceinline__ float bf2f(unsigned v) { return __uint_as_float(v << 16); }
__device__ __forceinline__ unsigned f2bf(float f) { unsigned u = __float_as_uint(f); return (u + 0x7fffu + ((u >> 16) & 1u)) >> 16; }
__device__ __forceinline__ unsigned pk2(float lo, float hi) { return f2bf(lo) | (f2bf(hi) << 16); }
__device__ __forceinline__ float wave_sum(float v) {
#pragma unroll
    for (int o = 1; o < 64; o <<= 1) v += __shfl_xor(v, o);
    return v;
}
__device__ __forceinline__ float wave_max(float v) {
#pragma unroll
    for (int o = 1; o < 64; o <<= 1) v = fmaxf(v, __shfl_xor(v, o));
    return v;
}
__device__ __forceinline__ float ex2(float v) { return __builtin_amdgcn_exp2f(v); }
__device__ __forceinline__ float sigmoidf_(float v) { return __builtin_amdgcn_rcpf(1.f + ex2(-v * LOG2E)); }
__device__ __forceinline__ int crow(int r, int hi) { return (r & 3) + 8 * (r >> 2) + 4 * hi; }

struct ColPlain { const float* W; int ld; __device__ __forceinline__ const float* ptr(int n) const { return W + n; } };
struct ColUp { const float* W1; const float* W3; int ld; __device__ __forceinline__ const float* ptr(int n) const { const int t = n >> 8, r = n & 255; const long long dlt = (r < 128) ? 0ll : (long long)(W3 - W1); return W1 + dlt + t * 128 + (r & 127); } };
struct ColWin { const float* W; int ld;
    __device__ __forceinline__ const float* ptr(int n) const {
        int s;
        if (n < 1536) s = n; else if (n < 2048) s = 1544 + (n - 1536); else if (n < 2112) s = 2056 + (n - 2048); else if (n < 2176) s = 2120 + (n - 2112);
        else if (n < 2432) s = 2184 + (n - 2176); else if (n < 2464) s = 2440 + (n - 2432); else if (n < 2472) s = 1536 + (n - 2464); else if (n < 2480) s = n;
        else if (n < 2560) s = -1; else if (n < 3584) s = 2480 + (n - 2560); else s = 3504 + (n - 3584);
        return s < 0 ? nullptr : W + s; } };
template <class CF> __device__ __forceinline__ void transpose_item(const CF& cf, int K, bf16_t* WT, LAS float* scr, int item, int nblk, int lane) {
    const int kb = item / nblk, nb = item % nblk, k0 = 64 * kb, n0 = 32 * nb;
    const float* cp = cf.ptr(n0 + (lane & 31));
#pragma unroll 1
    for (int h2 = 0; h2 < 2; ++h2) { float tv[16];
        const float* cq = cp ? cp + (size_t)(k0 + 32 * h2 + (lane >> 5)) * cf.ld : nullptr;
#pragma unroll
        for (int i = 0; i < 16; ++i) tv[i] = cq ? cq[(size_t)(2 * i) * cf.ld] : 0.f;
#pragma unroll
        for (int i = 0; i < 16; ++i) scr[(32 * h2 + 2 * i + (lane >> 5)) * 33 + (lane & 31)] = tv[i]; }
    asm volatile("s_waitcnt lgkmcnt(0)" ::: "memory");
    const int c = lane & 7;
#pragma unroll
    for (int j = 0; j < 4; ++j) { const int n = (lane >> 3) + 8 * j; const LAS float* s = scr + (8 * c) * 33 + n;
        u32x4 o; o.x = pk2(s[0 * 33], s[1 * 33]); o.y = pk2(s[2 * 33], s[3 * 33]); o.z = pk2(s[4 * 33], s[5 * 33]); o.w = pk2(s[6 * 33], s[7 * 33]);
        *(u32x4*)(WT + (size_t)(n0 + n) * K + k0 + 8 * c) = o; }
    asm volatile("s_waitcnt lgkmcnt(0)" ::: "memory");
}
__device__ __forceinline__ void phase_prologue(const Params& p, LAS unsigned char* lds) {
    const int tid = threadIdx.x, lane = tid & 63, wid = rfl(tid >> 6);
    float* mod = (float*)(p.ws + WS_MOD);
    if (blockIdx.x < NMOD / 64) {
        LAS float* sc = (LAS float*)lds;
        LAS float* red = (LAS float*)(lds + 32768);
        for (int i = tid; i < NB * DM; i += 512) { const float v = p.c[i]; sc[i] = v / (1.f + __expf(-v)); }
        __syncthreads();
        const int col = blockIdx.x * 64 + lane;
        float acc[NB];
#pragma unroll
        for (int b = 0; b < NB; ++b) acc[b] = 0.f;
#pragma unroll 16
        for (int k = wid; k < DM; k += 8) { const float w = p.ada_w[(size_t)k * NMOD + col];
#pragma unroll
            for (int b = 0; b < NB; ++b) acc[b] = fmaf(sc[b * DM + k], w, acc[b]); }
#pragma unroll
        for (int b = 0; b < NB; ++b) red[(wid * 8 + b) * 64 + lane] = acc[b];
        __syncthreads();
        { const int b = wid; float s = p.ada_b[col];
#pragma unroll
          for (int w = 0; w < 8; ++w) s += red[(w * 8 + b) * 64 + lane];
          mod[b * NMOD + col] = s; }
        __syncthreads();
    }
    LAS float* scr = (LAS float*)(lds + wid * 16384);
    const int gw = blockIdx.x * 8 + wid, NGW = gridDim.x * 8;
    constexpr int I_UP = (DM / 64) * (NUP / 32), I_DN = (FF / 64) * (DM / 32), I_IN = (DM / 64) * (NZ / 32), I_BR = (512 / 64) * (DM / 32), I_O = (DM / 64) * (DM / 32);
    constexpr int NITEMS = 2 * I_UP + 2 * I_DN + I_IN + 2 * I_BR + I_O;
    for (int it = gw; it < NITEMS; it += NGW) {
        int r = it;
        if (r < I_UP) { transpose_item(ColUp{p.f1w1, p.f1w3, FF}, DM, (bf16_t*)(p.ws + WS_WUP1), scr, r, NUP / 32, lane); continue; } r -= I_UP;
        if (r < I_UP) { transpose_item(ColUp{p.f2w1, p.f2w3, FF}, DM, (bf16_t*)(p.ws + WS_WUP2), scr, r, NUP / 32, lane); continue; } r -= I_UP;
        if (r < I_DN) { transpose_item(ColPlain{p.f1w2, DM}, FF, (bf16_t*)(p.ws + WS_WDN1), scr, r, DM / 32, lane); continue; } r -= I_DN;
        if (r < I_DN) { transpose_item(ColPlain{p.f2w2, DM}, FF, (bf16_t*)(p.ws + WS_WDN2), scr, r, DM / 32, lane); continue; } r -= I_DN;
        if (r < I_IN) { transpose_item(ColWin{p.w_in, 4528}, DM, (bf16_t*)(p.ws + WS_WIN), scr, r, NZ / 32, lane); continue; } r -= I_IN;
        if (r < I_BR) { transpose_item(ColPlain{p.wbf, DM}, 512, (bf16_t*)(p.ws + WS_WA), scr, r, DM / 32, lane); continue; } r -= I_BR;
        if (r < I_BR) { transpose_item(ColPlain{p.wbd, DM}, 512, (bf16_t*)(p.ws + WS_WB), scr, r, DM / 32, lane); continue; } r -= I_BR;
        transpose_item(ColPlain{p.wout, DM}, DM, (bf16_t*)(p.ws + WS_WO), scr, r, DM / 32, lane);
    }
}

__device__ __forceinline__ void phase_norm(const Params& p, const float* src, int sub) {
    const int tid = threadIdx.x, lane = tid & 63, wid = rfl(tid >> 6);
    const int gw = blockIdx.x * 8 + wid, NGW = gridDim.x * 8;
    const float* mod = (const float*)(p.ws + WS_MOD);
    bf16_t* HN = (bf16_t*)(p.ws + WS_HN);
    const float* g = p.norm_g + sub * DM;
    f32x4 gv[4];
#pragma unroll
    for (int j = 0; j < 4; ++j) gv[j] = *(const f32x4*)(g + 256 * j + 4 * lane);
    constexpr int RIF = 4;
    for (int m0 = gw; m0 < MT; m0 += RIF * NGW) {
        f32x4 v[RIF][4]; float ss[RIF];
#pragma unroll
        for (int t = 0; t < RIF; ++t) { const int m = m0 + t * NGW; const f32x4* xr = (const f32x4*)(src + (size_t)(m < MT ? m : m0) * DM) + lane;
#pragma unroll
            for (int j = 0; j < 4; ++j) { v[t][j] = xr[64 * j]; } }
#pragma unroll
        for (int t = 0; t < RIF; ++t) { float s = 0.f;
#pragma unroll
            for (int j = 0; j < 4; ++j) s += (v[t][j].x * v[t][j].x + v[t][j].y * v[t][j].y) + (v[t][j].z * v[t][j].z + v[t][j].w * v[t][j].w);
            ss[t] = s; }
#pragma unroll
        for (int t = 0; t < RIF; ++t) { const int m = m0 + t * NGW; if (m >= MT) break; const int b = m >> 13;
            const float* sh = mod + b * NMOD + (3 * sub + 0) * DM, *scl = mod + b * NMOD + (3 * sub + 1) * DM;
            const float rstd = 1.f / sqrtf(wave_sum(ss[t]) * (1.f / DM) + 1e-6f);
            u32x2* o8 = (u32x2*)(HN + (size_t)m * DM) + lane;
#pragma unroll
            for (int j = 0; j < 4; ++j) { const f32x4 sv = *(const f32x4*)(scl + 256 * j + 4 * lane), hv = *(const f32x4*)(sh + 256 * j + 4 * lane);
                const f32x4 y = (v[t][j] * rstd) * gv[j] * (sv + 1.f) + hv;
                u32x2 w; w.x = pk2(y.x, y.y); w.y = pk2(y.z, y.w); o8[64 * j] = w; } }
    }
}

__device__ __forceinline__ void phase_norm_bf(const Params& p, const bf16_t* src, int sub) {
    const int tid = threadIdx.x, lane = tid & 63, wid = rfl(tid >> 6);
    const int gw = blockIdx.x * 8 + wid, NGW = gridDim.x * 8;
    const float* mod = (const float*)(p.ws + WS_MOD);
    bf16_t* HN = (bf16_t*)(p.ws + WS_HN);
    const float* g = p.norm_g + sub * DM;
    float gf[2][8];
#pragma unroll
    for (int j = 0; j < 2; ++j) { const f32x4 ga = *(const f32x4*)(g + 512 * j + 8 * lane), gb = *(const f32x4*)(g + 512 * j + 8 * lane + 4);
        gf[j][0] = ga.x; gf[j][1] = ga.y; gf[j][2] = ga.z; gf[j][3] = ga.w; gf[j][4] = gb.x; gf[j][5] = gb.y; gf[j][6] = gb.z; gf[j][7] = gb.w; }
    constexpr int RIF = 4;
    for (int m0 = gw; m0 < MT; m0 += RIF * NGW) {
        u32x4 r[RIF][2]; float ss[RIF];
#pragma unroll
        for (int t = 0; t < RIF; ++t) { const int m = m0 + t * NGW; const bf16_t* xr = src + (size_t)(m < MT ? m : m0) * DM + 8 * lane;
            r[t][0] = *(const u32x4*)xr; r[t][1] = *(const u32x4*)(xr + 512); }
#pragma unroll
        for (int t = 0; t < RIF; ++t) { float s = 0.f;
#pragma unroll
            for (int j = 0; j < 2; ++j)
#pragma unroll
                for (int e = 0; e < 4; ++e) { const float lo = bf2f(r[t][j][e] & 0xffffu), hi = bf2f(r[t][j][e] >> 16); s += lo * lo + hi * hi; }
            ss[t] = s; }
#pragma unroll
        for (int t = 0; t < RIF; ++t) { const int m = m0 + t * NGW; if (m >= MT) break; const int b = m >> 13;
            const float* sh = mod + b * NMOD + (3 * sub + 0) * DM, *scl = mod + b * NMOD + (3 * sub + 1) * DM;
            const float rstd = 1.f / sqrtf(wave_sum(ss[t]) * (1.f / DM) + 1e-6f);
#pragma unroll
            for (int j = 0; j < 2; ++j) { const f32x4 sa = *(const f32x4*)(scl + 512 * j + 8 * lane), sb = *(const f32x4*)(scl + 512 * j + 8 * lane + 4), ha = *(const f32x4*)(sh + 512 * j + 8 * lane), hb = *(const f32x4*)(sh + 512 * j + 8 * lane + 4);
                const float sv[8] = {sa.x, sa.y, sa.z, sa.w, sb.x, sb.y, sb.z, sb.w}, hv[8] = {ha.x, ha.y, ha.z, ha.w, hb.x, hb.y, hb.z, hb.w};
                float y[8];
#pragma unroll
                for (int e = 0; e < 4; ++e) { const float lo = bf2f(r[t][j][e] & 0xffffu), hi = bf2f(r[t][j][e] >> 16);
                    y[2 * e] = lo * rstd * gf[j][2 * e] * (sv[2 * e] + 1.f) + hv[2 * e]; y[2 * e + 1] = hi * rstd * gf[j][2 * e + 1] * (sv[2 * e + 1] + 1.f) + hv[2 * e + 1]; }
                u32x4 w; w.x = pk2(y[0], y[1]); w.y = pk2(y[2], y[3]); w.z = pk2(y[4], y[5]); w.w = pk2(y[6], y[7]);
                *(u32x4*)(HN + (size_t)m * DM + 512 * j + 8 * lane) = w; } }
    }
}

using pg8::Unit;
struct EpiSwiglu { static constexpr bool PERM = true, AFTER_DRAIN = false; bf16_t* H;
    __device__ __forceinline__ void operator()(const f32x4 (&acc)[2][2][4][2], const Unit& u, int wr, int wc, int fr, int fq) const {
        const int row0 = u.pm * 256 + wr * 64 + fr, col0 = u.pn * 128 + wc * 32 + 8 * fq;
#pragma unroll
        for (int ai = 0; ai < 2; ++ai)
#pragma unroll
            for (int m = 0; m < 4; ++m) { bf16_t* rowp = H + (size_t)(row0 + ai * 128 + m * 16) * FF + col0;
                float h[8];
#pragma unroll
                for (int n = 0; n < 2; ++n)
#pragma unroll
                    for (int e = 0; e < 4; ++e) { const float g = acc[ai][0][m][n][e], uu = acc[ai][1][m][n][e]; h[4 * n + e] = g * sigmoidf_(g) * uu; }
                u32x4 w; w.x = pg8::cvt_pk_bf16(h[0], h[1]); w.y = pg8::cvt_pk_bf16(h[2], h[3]); w.z = pg8::cvt_pk_bf16(h[4], h[5]); w.w = pg8::cvt_pk_bf16(h[6], h[7]);
                *(u32x4*)rowp = w; }
    } };
template <bool BASE_BF, bool OUT_BF> struct EpiResidT { static constexpr bool PERM = true, AFTER_DRAIN = false; const void* base; void* out; const float* gate; float coef;
    __device__ __forceinline__ void operator()(const f32x4 (&acc)[2][2][4][2], const Unit& u, int wr, int wc, int fr, int fq) const {
        const int row0 = u.pm * 256 + wr * 64 + fr, col0 = u.pn * 256 + wc * 32 + 8 * fq, b = (u.pm * 256) >> 13;
        f32x4 gv[2][2];
#pragma unroll
        for (int bj = 0; bj < 2; ++bj)
#pragma unroll
            for (int n = 0; n < 2; ++n) gv[bj][n] = *(const f32x4*)(gate + b * NMOD + col0 + bj * 128 + n * 4) * coef;
#pragma unroll
        for (int ai = 0; ai < 2; ++ai)
#pragma unroll
            for (int m = 0; m < 4; ++m) { const size_t off = (size_t)(row0 + ai * 128 + m * 16) * DM + col0;
#pragma unroll
                for (int bj = 0; bj < 2; ++bj) { f32x4 b0, b1;
                    if (BASE_BF) { const u32x4 r = *(const u32x4*)((const bf16_t*)base + off + bj * 128);
                        b0 = (f32x4){bf2f(r.x & 0xffffu), bf2f(r.x >> 16), bf2f(r.y & 0xffffu), bf2f(r.y >> 16)}; b1 = (f32x4){bf2f(r.z & 0xffffu), bf2f(r.z >> 16), bf2f(r.w & 0xffffu), bf2f(r.w >> 16)}; }
                    else { b0 = *(const f32x4*)((const float*)base + off + bj * 128); b1 = *(const f32x4*)((const float*)base + off + bj * 128 + 4); }
                    const f32x4 o0 = b0 + gv[bj][0] * acc[ai][bj][m][0], o1 = b1 + gv[bj][1] * acc[ai][bj][m][1];
                    if (OUT_BF) { u32x4 w; w.x = pg8::cvt_pk_bf16(o0.x, o0.y); w.y = pg8::cvt_pk_bf16(o0.z, o0.w); w.z = pg8::cvt_pk_bf16(o1.x, o1.y); w.w = pg8::cvt_pk_bf16(o1.z, o1.w);
                        *(u32x4*)((bf16_t*)out + off + bj * 128) = w; }
                    else { *(f32x4*)((float*)out + off + bj * 128) = o0; *(f32x4*)((float*)out + off + bj * 128 + 4) = o1; } } }
    } };
struct EpiZ { static constexpr bool PERM = true, AFTER_DRAIN = false; bf16_t* Z; float* side;
    __device__ __forceinline__ void operator()(const f32x4 (&acc)[2][2][4][2], const Unit& u, int wr, int wc, int fr, int fq) const {
        const int row0 = u.pm * 256 + wr * 64 + fr, col0 = u.pn * 256 + wc * 32 + 8 * fq;
#pragma unroll
        for (int ai = 0; ai < 2; ++ai)
#pragma unroll
            for (int m = 0; m < 4; ++m) { const int row = row0 + ai * 128 + m * 16; bf16_t* rowp = Z + (size_t)row * NZ + col0;
#pragma unroll
                for (int bj = 0; bj < 2; ++bj) { const f32x4 v0 = acc[ai][bj][m][0], v1 = acc[ai][bj][m][1];
                    u32x4 w; w.x = pg8::cvt_pk_bf16(v0[0], v0[1]); w.y = pg8::cvt_pk_bf16(v0[2], v0[3]); w.z = pg8::cvt_pk_bf16(v1[0], v1[1]); w.w = pg8::cvt_pk_bf16(v1[2], v1[3]);
                    *(u32x4*)(rowp + bj * 128) = w; }
                if (u.pn == 9 && wc == 1 && fq < 2) {
                    float* sp = side + (size_t)row * 16 + 8 * fq; *(f32x4*)sp = acc[ai][1][m][0]; *(f32x4*)(sp + 4) = acc[ai][1][m][1]; } }
    } };
template <bool SECOND> struct EpiGate { static constexpr bool PERM = true, AFTER_DRAIN = false; bf16_t* MG; const bf16_t* Zg;
    __device__ __forceinline__ void operator()(const f32x4 (&acc)[2][2][4][2], const Unit& u, int wr, int wc, int fr, int fq) const {
        const int row0 = u.pm * 256 + wr * 64 + fr, col0 = u.pn * 256 + wc * 32 + 8 * fq;
#pragma unroll
        for (int ai = 0; ai < 2; ++ai)
#pragma unroll
            for (int m = 0; m < 4; ++m) { const int row = row0 + ai * 128 + m * 16;
#pragma unroll
                for (int bj = 0; bj < 2; ++bj) { const u32x4 gr = *(const u32x4*)(Zg + (size_t)row * NZ + col0 + bj * 128);
                    bf16_t* mp = MG + (size_t)row * DM + col0 + bj * 128;
                    float o[8];
#pragma unroll
                    for (int e = 0; e < 4; ++e) { const float a = acc[ai][bj][m][e >> 1][2 * (e & 1)], bq = acc[ai][bj][m][e >> 1][2 * (e & 1) + 1];
                        o[2 * e] = a * sigmoidf_(bf2f(gr[e] & 0xffffu)); o[2 * e + 1] = bq * sigmoidf_(bf2f(gr[e] >> 16)); }
                    if (SECOND) { const u32x4 pr = *(const u32x4*)mp;
#pragma unroll
                        for (int e = 0; e < 4; ++e) { o[2 * e] += bf2f(pr[e] & 0xffffu); o[2 * e + 1] += bf2f(pr[e] >> 16); } }
                    u32x4 w; w.x = pg8::cvt_pk_bf16(o[0], o[1]); w.y = pg8::cvt_pk_bf16(o[2], o[3]); w.z = pg8::cvt_pk_bf16(o[4], o[5]); w.w = pg8::cvt_pk_bf16(o[6], o[7]);
                    *(u32x4*)mp = w; } }
    } };

__device__ __forceinline__ void unpack8(const u32x4 r, float (&v)[8]) {
#pragma unroll
    for (int e = 0; e < 4; ++e) { v[2 * e] = bf2f(r[e] & 0xffffu); v[2 * e + 1] = bf2f(r[e] >> 16); } }
__device__ __forceinline__ u32x4 pack8(const float (&v)[8]) { u32x4 w; w.x = pk2(v[0], v[1]); w.y = pk2(v[2], v[3]); w.z = pk2(v[4], v[5]); w.w = pk2(v[6], v[7]); return w; }
__device__ __forceinline__ float grp8_sum(float s) { s += __shfl_xor(s, 1); s += __shfl_xor(s, 2); s += __shfl_xor(s, 4); return s; }
__device__ __forceinline__ void phase_post(const Params& p) {
    const int tid = threadIdx.x, lane = tid & 63, wid = rfl(tid >> 6);
    const int gw = blockIdx.x * 8 + wid, NGW = gridDim.x * 8;
    bf16_t* Z = (bf16_t*)(p.ws + WS_Z);
    const float* side = (const float*)(p.ws + WS_SIDE);
    float* LF = (float*)(p.ws + WS_LF); float* WQ = (float*)(p.ws + WS_WQ);
    const int d8 = 8 * (lane & 7);
    float gfq[8], gfk[8], gdq[8], gdk[8];
#pragma unroll
    for (int e = 0; e < 8; ++e) { gfq[e] = p.fox_g[d8 + e] * C2; gfk[e] = p.fox_g[64 + d8 + e]; gdq[e] = p.dsa_g[d8 + e] * C2; gdk[e] = p.dsa_g[64 + d8 + e]; }
    float myinv = p.invfA[0];
#pragma unroll
    for (int e = 1; e < 8; ++e) if (lane == e) myinv = p.invfA[e];
#pragma unroll
    for (int e = 0; e < 4; ++e) if (lane >= 8 && (lane & 3) == e) myinv = p.invfI[e];
    u32x4 nx_q, nx_k, nx_dq, nx_c4; int nx_pos = 0;
    if (gw < MT) { const bf16_t* z0 = Z + (size_t)gw * NZ; nx_q = *(const u32x4*)(z0 + ZQ + 8 * lane); nx_k = *(const u32x4*)(z0 + ZK + 8 * lane); nx_dq = *(const u32x4*)(z0 + ZDQ + 8 * lane); nx_c4 = *(const u32x4*)(z0 + ZDK + 8 * lane); nx_pos = p.pos[gw]; }
    for (int m = gw; m < MT; m += NGW) {
        bf16_t* zr = Z + (size_t)m * NZ;
        const u32x4 ld_q = nx_q, ld_k = nx_k, ld_dq = nx_dq, ld_c4 = nx_c4;
        const int posm = nx_pos;
        if (m + NGW < MT) { const bf16_t* z1 = Z + (size_t)(m + NGW) * NZ; nx_q = *(const u32x4*)(z1 + ZQ + 8 * lane); nx_k = *(const u32x4*)(z1 + ZK + 8 * lane); nx_dq = *(const u32x4*)(z1 + ZDQ + 8 * lane); nx_c4 = *(const u32x4*)(z1 + ZDK + 8 * lane); nx_pos = p.pos[m + NGW]; }
        const float ang = (float)posm * myinv;
        const double rev = (double)ang * 0.15915494309189535; const float fr = (float)(rev - rint(rev));
        const float cs = __builtin_amdgcn_cosf(fr), sn = __builtin_amdgcn_sinf(fr);
        float cA[8], sA[8], cI[4], sI[4];
#pragma unroll
        for (int e = 0; e < 8; ++e) { cA[e] = __shfl(cs, e); sA[e] = __shfl(sn, e); }
#pragma unroll
        for (int e = 0; e < 4; ++e) { cI[e] = __shfl(cs, 8 + e); sI[e] = __shfl(sn, 8 + e); }
        float v[8];
        { u32x4 r = ld_q; unpack8(r, v); float s = 0.f;
#pragma unroll
          for (int e = 0; e < 8; ++e) s += v[e] * v[e];
          const float rs = 1.f / sqrtf(grp8_sum(s) * (1.f / 64.f) + 1e-6f);
#pragma unroll
          for (int e = 0; e < 8; ++e) v[e] = v[e] * rs * gfq[e];
          *(u32x4*)(zr + ZQ + 8 * lane) = pack8(v); }
        { u32x4 r = ld_k; unpack8(r, v); float s = 0.f;
#pragma unroll
          for (int e = 0; e < 8; ++e) s += v[e] * v[e];
          const float rs = 1.f / sqrtf(grp8_sum(s) * (1.f / 64.f) + 1e-6f);
#pragma unroll
          for (int e = 0; e < 8; ++e) v[e] = v[e] * rs * gfk[e];
          *(u32x4*)(zr + ZK + 8 * lane) = pack8(v); }
        { u32x4 r = ld_dq; unpack8(r, v); float s = 0.f;
#pragma unroll
          for (int e = 0; e < 8; ++e) s += v[e] * v[e];
          const float rs = 1.f / sqrtf(grp8_sum(s) * (1.f / 64.f) + 1e-6f);
          const int li = lane & 7;
#pragma unroll
          for (int e = 0; e < 8; ++e) { const float y = v[e] * rs * p.dsa_g[d8 + e]; const float o = __shfl_xor(y, 1);
              v[e] = (li == 0 ? y * cA[e] - o * sA[e] : li == 1 ? y * cA[e] + o * sA[e] : y) * C2; }
          *(u32x4*)(zr + ZDQ + 8 * lane) = pack8(v); }
        { u32x4 r = ld_c4; unpack8(r, v); float s = 0.f;
#pragma unroll
          for (int e = 0; e < 8; ++e) s += v[e] * v[e];
          const float rs = 1.f / sqrtf(grp8_sum(s) * (1.f / 64.f) + 1e-6f);
          float y[8], o[8];
#pragma unroll
          for (int e = 0; e < 8; ++e) { y[e] = v[e] * rs * gdk[e]; o[e] = __shfl_xor(y[e], 1); }
          if (lane < 8) {
#pragma unroll
              for (int e = 0; e < 8; ++e) v[e] = lane == 0 ? y[e] * cA[e] - o[e] * sA[e] : lane == 1 ? y[e] * cA[e] + o[e] * sA[e] : y[e];
              *(u32x4*)(zr + ZDK + 8 * lane) = pack8(v);
          } else if ((lane >= 16 && lane < 48 && ((lane - 16) & 3) == 0) || lane == 48) {
              float w[8];
#pragma unroll
              for (int e = 0; e < 4; ++e) { w[e] = v[e] * cI[e] - v[e + 4] * sI[e]; w[e + 4] = v[e + 4] * cI[e] + v[e] * sI[e]; }
              *(u32x4*)(zr + ZDK + 8 * lane) = pack8(w);
          } else if (lane >= 8 && lane < 16) { const int e = lane - 8;
              const float xx = side[(size_t)m * 16 + e] + p.fbias[e]; LF[(size_t)m * 8 + e] = fminf(xx, 0.f) - log1pf(__expf(-fabsf(xx)));
          } else if (lane >= 52 && lane < 60) { const int e = lane - 52;
              WQ[(size_t)m * 8 + e] = side[(size_t)m * 16 + 8 + e] * 0.0625f;
          } }
    }
}

__device__ __forceinline__ void phase_cumsum(const Params& p, LAS unsigned char* lds) {
    if (blockIdx.x >= 64) return;
    const int tid = threadIdx.x, lane = tid & 63, wid = rfl(tid >> 6);
    const int b = blockIdx.x >> 3, h = blockIdx.x & 7;
    const float* LF = (const float*)(p.ws + WS_LF); float* F2 = (float*)(p.ws + WS_F2) + (size_t)blockIdx.x * SEQ;
    LAS double* wt = (LAS double*)lds;
    float v[16]; float run = 0.f; const int s0 = 16 * tid;
#pragma unroll
    for (int i = 0; i < 16; ++i) { run += LF[((size_t)b * SEQ + s0 + i) * 8 + h]; v[i] = run; }
    double inc = (double)run;
#pragma unroll
    for (int o = 1; o < 64; o <<= 1) { const double t = __shfl_up(inc, o); if (lane >= o) inc += t; }
    if (lane == 63) wt[wid] = inc;
    __syncthreads();
    double pre = inc - (double)run;
    for (int w = 0; w < wid; ++w) pre += wt[w];
#pragma unroll
    for (int i = 0; i < 16; ++i) F2[s0 + i] = (float)((pre + (double)v[i]) * 1.4426950408889634);
    __syncthreads();
}

__device__ __forceinline__ f32x16 mfma32(bf16x8 a, bf16x8 b, f32x16 c) { return __builtin_amdgcn_mfma_f32_32x32x16_bf16(a, b, c, 0, 0, 0); }
__device__ __forceinline__ f32x4 mfma16(bf16x8 a, bf16x8 b, f32x4 c) { return __builtin_amdgcn_mfma_f32_16x16x32_bf16(a, b, c, 0, 0, 0); }
__device__ __forceinline__ s16x4 vtr(LAS const unsigned char* pp) { return __builtin_bit_cast(s16x4, __builtin_amdgcn_ds_read_tr16_b64_v4i16((LAS s16x4*)pp)); }
#ifndef FOX_SKIP
#define FOX_SKIP 1
#endif
__device__ __forceinline__ void fox_tile(LAS const unsigned char* Kb, LAS const unsigned char* Vb, LAS const float* Fb, LAS float* wsf, const bf16x8 (&qr)[4], float Fq, int kt, int kt_my_last, int qw,
                                         int r32, int hi, int trq, int trp, float& m_run, float& l_run, f32x16& o0, f32x16& o1) {
    constexpr int KST = 144;


            f32x16 p0, p1;
#pragma unroll
            for (int g4 = 0; g4 < 4; ++g4) { const f32x4 fa = *(LAS const f32x4*)(Fb + 8 * g4 + 4 * hi), fb = *(LAS const f32x4*)(Fb + 32 + 8 * g4 + 4 * hi);
#pragma unroll
                for (int i = 0; i < 4; ++i) { p0[4 * g4 + i] = fa[i]; p1[4 * g4 + i] = fb[i]; } }
#pragma unroll
            for (int d0 = 0; d0 < 4; ++d0) { const bf16x8 a0 = *(LAS const bf16x8*)(Kb + r32 * KST + (d0 * 16 + hi * 8) * 2), a1 = *(LAS const bf16x8*)(Kb + (32 + r32) * KST + (d0 * 16 + hi * 8) * 2);
                p0 = mfma32(a0, qr[d0], p0); p1 = mfma32(a1, qr[d0], p1); }
            if (kt == kt_my_last) { const int qrel = qw + r32 - kt * 64;
#pragma unroll
                for (int r = 0; r < 16; ++r) { const int kv = crow(r, hi); if (kv > qrel) p0[r] = -INFINITY; if (kv + 32 > qrel) p1[r] = -INFINITY; } }
            float rm = fmaxf(p0[0], p1[0]);
#pragma unroll
            for (int r = 1; r < 16; ++r) rm = fmaxf(rm, fmaxf(p0[r], p1[r]));
            rm = fmaxf(rm, __shfl_xor(rm, 32));
            if (__any(rm > m_run)) {
                const float mn = fmaxf(m_run, rm); const float alpha = ex2(m_run - mn); m_run = mn; l_run *= alpha;
                if (hi == 0) wsf[r32] = alpha;
#pragma unroll
                for (int g4 = 0; g4 < 4; ++g4) { const f32x4 al = *(LAS const f32x4*)(wsf + 8 * g4 + 4 * hi);
#pragma unroll
                    for (int i = 0; i < 4; ++i) { o0[4 * g4 + i] *= al[i]; o1[4 * g4 + i] *= al[i]; } } }
            float sum = 0.f;
#pragma unroll
            for (int r = 0; r < 16; ++r) { p0[r] = ex2(p0[r] - m_run); p1[r] = ex2(p1[r] - m_run); sum += p0[r] + p1[r]; }
            sum += __shfl_xor(sum, 32); l_run += sum;
            bf16x8 pa[4];
#pragma unroll
            for (int s = 0; s < 2; ++s) { u32x4 w0, w1;
#pragma unroll
                for (int e = 0; e < 4; ++e) { w0[e] = pg8::cvt_pk_bf16(p0[8 * s + 2 * e], p0[8 * s + 2 * e + 1]); w1[e] = pg8::cvt_pk_bf16(p1[8 * s + 2 * e], p1[8 * s + 2 * e + 1]); }
                pa[s] = __builtin_bit_cast(bf16x8, w0); pa[2 + s] = __builtin_bit_cast(bf16x8, w1); }
#pragma unroll
            for (int ks = 0; ks < 4; ++ks) {
#pragma unroll
                for (int d0 = 0; d0 < 2; ++d0) { LAS const unsigned char* vp = Vb + (16 * ks + 4 * hi + trq) * KST + (32 * d0 + 16 * (r32 >> 4) + 4 * trp) * 2;
                    const s16x4 lo = vtr(vp), hh = vtr(vp + 8 * KST);
                    const bf16x8 vf = (bf16x8){lo[0], lo[1], lo[2], lo[3], hh[0], hh[1], hh[2], hh[3]};
                    if (d0 == 0) o0 = mfma32(pa[ks], vf, o0); else o1 = mfma32(pa[ks], vf, o1); } }

}
__device__ __forceinline__ void fox_unit(const Params& p, LAS unsigned char* lds, int b, int h, int qb, float thr2) {
    const int tid = threadIdx.x, lane = tid & 63, r32 = lane & 31, hi = lane >> 5, wid = rfl(tid >> 6);
    const bf16_t* Z = (const bf16_t*)(p.ws + WS_Z);
    bf16_t* Y = (bf16_t*)(p.ws + WS_Y);
    const float* F2 = (const float*)(p.ws + WS_F2) + (size_t)(b * 8 + h) * SEQ;
    const int q0 = qb * 256, qw = q0 + wid * 32;
    const size_t rowb = (size_t)b * SEQ;
    constexpr int KST = 144, KBYTES = 64 * KST;
    LAS unsigned char* Kl = lds; LAS unsigned char* Vl = lds + 4 * KBYTES; LAS float* Fl = (LAS float*)(lds + 8 * KBYTES); LAS float* wsf = (LAS float*)(lds + 8 * KBYTES + 1024) + wid * 64;
    const int NT = 4 * qb + 4;
    const int kt_my_last = qw >> 6, st_last = NT / 2 - 1;
    const int srow = tid >> 3, sch = tid & 7;
    const bf16_t* kg = Z + (rowb + srow) * NZ + ZK + h * 64 + sch * 8; const bf16_t* vg = Z + (rowb + srow) * NZ + ZV + h * 64 + sch * 8;
    u32x4 kra, krb, vra, vrb; float freg = 0.f;
#define FX_LOAD(st) do { kra = *(const u32x4*)(kg + (size_t)(st) * 128 * NZ); krb = *(const u32x4*)(kg + ((size_t)(st) * 128 + 64) * NZ); \
        vra = *(const u32x4*)(vg + (size_t)(st) * 128 * NZ); vrb = *(const u32x4*)(vg + ((size_t)(st) * 128 + 64) * NZ); if (tid < 128) freg = F2[(st) * 128 + tid]; } while (0)
#define FX_STORE(bf) do { *(LAS u32x4*)(Kl + (2 * (bf)) * KBYTES + srow * KST + sch * 16) = kra; *(LAS u32x4*)(Kl + (2 * (bf) + 1) * KBYTES + srow * KST + sch * 16) = krb; \
        *(LAS u32x4*)(Vl + (2 * (bf)) * KBYTES + srow * KST + sch * 16) = vra; *(LAS u32x4*)(Vl + (2 * (bf) + 1) * KBYTES + srow * KST + sch * 16) = vrb; if (tid < 128) Fl[(bf) * 128 + tid] = Fref - freg; } while (0)
    FX_LOAD(st_last);
    bf16x8 qr[4];
    { const bf16_t* qp = Z + (rowb + qw + r32) * NZ + ZQ + h * 64 + hi * 8;
#pragma unroll
      for (int d0 = 0; d0 < 4; ++d0) qr[d0] = *(const bf16x8*)(qp + d0 * 16); }
    const float Fq = 0.f, Fref = F2[q0];
    int kt0 = 0, ktw = 0;
#if FOX_SKIP
    { const float Fw = F2[qw]; const int ta = lane, tb = lane + 64;
      const float fu = tid < NT - 4 ? F2[64 * tid + 63] : 0.f, fa = ta < NT - 4 ? F2[64 * ta + 63] : 0.f, fb = tb < NT - 4 ? F2[64 * tb + 63] : 0.f;
      kt0 = __syncthreads_count((tid < NT - 4 && (fu - Fref) > thr2) ? 1 : 0);
      const bool pa = ta < NT - 4 && (fa - Fw) > thr2, pb = tb < NT - 4 && (fb - Fw) > thr2;
      ktw = __popcll(__ballot(pa)) + __popcll(__ballot(pb)); }
#endif
    float m_run = -INFINITY, l_run = 0.f; f32x16 o0, o1;
#pragma unroll
    for (int r = 0; r < 16; ++r) { o0[r] = 0.f; o1[r] = 0.f; }
    const int st0 = kt0 >> 1;
    FX_STORE(0); __syncthreads();
    const int trq = (lane & 15) >> 2, trp = lane & 3;
    for (int st = st_last; st >= st0; --st) {
        const int buf = (st_last - st) & 1;
        if (st > st0) FX_LOAD(st - 1);
        if (2 * st + 1 >= ktw && 2 * st + 1 <= kt_my_last) fox_tile(Kl + (2 * buf + 1) * KBYTES, Vl + (2 * buf + 1) * KBYTES, Fl + buf * 128 + 64, wsf, qr, Fq, 2 * st + 1, kt_my_last, qw, r32, hi, trq, trp, m_run, l_run, o0, o1);
        if (2 * st >= ktw && 2 * st <= kt_my_last) fox_tile(Kl + (2 * buf) * KBYTES, Vl + (2 * buf) * KBYTES, Fl + buf * 128, wsf, qr, Fq, 2 * st, kt_my_last, qw, r32, hi, trq, trp, m_run, l_run, o0, o1);
        if (st > st0) FX_STORE(buf ^ 1);
        __syncthreads();
    }
#undef FX_LOAD
#undef FX_STORE
    if (hi == 0) wsf[32 + r32] = l_run;
#pragma unroll
    for (int g4 = 0; g4 < 4; ++g4) { const f32x4 lv = *(LAS const f32x4*)(wsf + 32 + 8 * g4 + 4 * hi);
#pragma unroll
        for (int i = 0; i < 4; ++i) { const int r = 4 * g4 + i; const float rl = 1.f / lv[i]; bf16_t* yp = Y + (rowb + qw + crow(r, hi)) * 512 + h * 64 + r32;
            yp[0] = (bf16_t)f2bf(o0[r] * rl); yp[32] = (bf16_t)f2bf(o1[r] * rl); } }
}

__device__ __forceinline__ unsigned sortable(float f) { const unsigned u = __float_as_uint(f); return u ^ ((unsigned)((int)u >> 31) | 0x80000000u); }
constexpr int DS_HIST = 0, DS_CAND = 0, DS_SEL = 65792, DS_PREF = 98560, DS_REM = DS_PREF + 256, DS_CNT = DS_REM + 256, DS_CEQ = DS_CNT + 256, DS_CCNT = DS_CEQ + 256, DS_PREF1 = DS_CCNT + 256, DS_IQ = DS_PREF1 + 256, DS_WQ = DS_IQ + 64 * 528, DS_VST = 0;
constexpr int DS_CAP = 256;
__device__ __forceinline__ int mapA(unsigned key) { const int t = (int)(key >> 20); const int dp = 128 + min(max(t - 2992, 0), 127), dn = min(max(t - 976, 0), 127); return t >= 2048 ? dp : dn; }
__device__ __forceinline__ int bucketf(float f) { const unsigned u = __float_as_uint(f); const int idx = (int)((u >> 20) & 0x7FFu); const int c = min(max(idx - 816, 128), 255); return c ^ (((int)u >> 31) & 255); }
typedef float f32x2v __attribute__((ext_vector_type(2)));
template <int MODE> __device__ __forceinline__ void dsa_sweep(const bf16_t* Zb, int c, int wid, int lane, LAS unsigned char* lds, unsigned pref, unsigned pref2 = 0u) {
    constexpr int SHIFT = 24 - 8 * (MODE & 3);
    const int r32 = lane & 31, hi = lane >> 5, ql = 32 * (wid & 1) + r32;
    LAS unsigned* hist = (LAS unsigned*)(lds + DS_HIST) + ql;   LAS unsigned short* sel = (LAS unsigned short*)(lds + DS_SEL) + ql * 256; LAS unsigned* cnt = (LAS unsigned*)(lds + DS_CNT) + ql;
    LAS unsigned* cand = (LAS unsigned*)(lds + DS_CAND) + ql * DS_CAP; LAS unsigned* ccnt = (LAS unsigned*)(lds + DS_CCNT) + ql;
    LAS const unsigned char* iqb = lds + DS_IQ + ql * 528 + hi * 16; LAS const float* wqb = (LAS const float*)(lds + DS_WQ) + ql;
    const int kt0 = wid >> 1; const int nit = kt0 <= c ? 2 * ((c - kt0) / 4 + 1) : 0;
    const bf16_t* ikp = Zb + (size_t)(64 * kt0 + r32) * NZ + ZIK + hi * 8;
    bf16x8 a0, a1;
    if (nit > 0) { a0 = *(const bf16x8*)ikp; a1 = *(const bf16x8*)(ikp + 16); }
#pragma unroll 1
    for (int it = 0; it < nit; ++it) {
        const int kt = kt0 + 4 * (it >> 1), kb = it & 1;
        const int itn = it + 1 < nit ? it + 1 : it;
        const bf16_t* np = ikp + (size_t)(256 * (itn >> 1) + 32 * (itn & 1)) * NZ; const bf16x8 n0 = *(const bf16x8*)np, n1 = *(const bf16x8*)(np + 16);
        f32x2v sc2[8];
#pragma unroll
        for (int r = 0; r < 8; ++r) sc2[r] = (f32x2v){0.f, 0.f};
#define SW_MF(hp, D0, D1, W0, W1) do { const bf16x8 b00 = *(LAS const bf16x8*)(iqb + (2 * (hp)) * 64), b01 = *(LAS const bf16x8*)(iqb + (2 * (hp)) * 64 + 32), \
            b10 = *(LAS const bf16x8*)(iqb + (2 * (hp) + 1) * 64), b11 = *(LAS const bf16x8*)(iqb + (2 * (hp) + 1) * 64 + 32); W0 = wqb[(2 * (hp)) * 64]; W1 = wqb[(2 * (hp) + 1) * 64]; \
            D0 = mfma32(a0, b00, zero16); D1 = mfma32(a0, b10, zero16); D0 = mfma32(a1, b01, D0); D1 = mfma32(a1, b11, D1); } while (0)
#define SW_VA(D0, D1, W0, W1) do { const f32x2v w0_ = (f32x2v){W0, W0}, w1_ = (f32x2v){W1, W1}; \
            _Pragma("unroll") for (int r = 0; r < 8; ++r) { const f32x2v e0 = (f32x2v){fmaxf(D0[2 * r], 0.f), fmaxf(D0[2 * r + 1], 0.f)}, e1 = (f32x2v){fmaxf(D1[2 * r], 0.f), fmaxf(D1[2 * r + 1], 0.f)}; \
                sc2[r] = __builtin_elementwise_fma(e0, w0_, sc2[r]); sc2[r] = __builtin_elementwise_fma(e1, w1_, sc2[r]); } } while (0)
        { f32x16 zero16;
#pragma unroll
          for (int r = 0; r < 16; ++r) zero16[r] = 0.f;
          f32x16 dA0, dA1, dB0, dB1; float wA0, wA1, wB0, wB1;
          SW_MF(0, dA0, dA1, wA0, wA1);
          SW_MF(1, dB0, dB1, wB0, wB1); __builtin_amdgcn_sched_barrier(0);
          SW_VA(dA0, dA1, wA0, wA1);    __builtin_amdgcn_sched_barrier(0);
          SW_MF(2, dA0, dA1, wA0, wA1); __builtin_amdgcn_sched_barrier(0);
          SW_VA(dB0, dB1, wB0, wB1);    __builtin_amdgcn_sched_barrier(0);
          SW_MF(3, dB0, dB1, wB0, wB1); __builtin_amdgcn_sched_barrier(0);
          SW_VA(dA0, dA1, wA0, wA1);    __builtin_amdgcn_sched_barrier(0);
          SW_VA(dB0, dB1, wB0, wB1); }
#undef SW_MF
#undef SW_VA
        f32x16 sc;
#pragma unroll
        for (int r = 0; r < 16; ++r) sc[r] = sc2[r >> 1][r & 1];
        const unsigned s0 = (unsigned)(64 * kt + 32 * kb + 4 * hi);
#pragma unroll
        for (int r = 0; r < 16; ++r) { const unsigned s = s0 + (unsigned)((r & 3) + 8 * (r >> 2));
            if (MODE == 5) { __hip_atomic_fetch_add(hist + 64 * bucketf(sc[r]), 1u, __ATOMIC_RELAXED, __HIP_MEMORY_SCOPE_WORKGROUP); continue; }
            if (MODE == 6) { const int dA = bucketf(sc[r]);
                if (dA > (int)pref) { const unsigned pos = __hip_atomic_fetch_add(cnt, 1u, __ATOMIC_RELAXED, __HIP_MEMORY_SCOPE_WORKGROUP); sel[pos & 255u] = (unsigned short)s; }
                else if (dA == (int)pref) { const unsigned key = (sortable(sc[r]) & 0xFFFFE000u) | (8191u - s);
                    const unsigned pos = __hip_atomic_fetch_add(ccnt, 1u, __ATOMIC_RELAXED, __HIP_MEMORY_SCOPE_WORKGROUP); cand[pos & (DS_CAP - 1)] = key; }
                continue; }
            if (MODE == 7) { if (bucketf(sc[r]) == (int)pref) { const unsigned key = (sortable(sc[r]) & 0xFFFFE000u) | (8191u - s);
                    __hip_atomic_fetch_add(hist + 64 * ((key >> 12) & 255u), 1u, __ATOMIC_RELAXED, __HIP_MEMORY_SCOPE_WORKGROUP); } continue; }
            if (MODE == 8) { const int dA = bucketf(sc[r]);
                if (dA > (int)pref) { const unsigned pos = __hip_atomic_fetch_add(cnt, 1u, __ATOMIC_RELAXED, __HIP_MEMORY_SCOPE_WORKGROUP); sel[pos & 255u] = (unsigned short)s; }
                else if (dA == (int)pref) { const unsigned key = (sortable(sc[r]) & 0xFFFFE000u) | (8191u - s); const unsigned sub = (key >> 12) & 255u;
                    if (sub > pref2) { const unsigned pos = __hip_atomic_fetch_add(cnt, 1u, __ATOMIC_RELAXED, __HIP_MEMORY_SCOPE_WORKGROUP); sel[pos & 255u] = (unsigned short)s; }
                    else if (sub == pref2) { const unsigned pos = __hip_atomic_fetch_add(ccnt, 1u, __ATOMIC_RELAXED, __HIP_MEMORY_SCOPE_WORKGROUP); cand[pos & (DS_CAP - 1)] = key; } }
                continue; }
            const unsigned key = (sortable(sc[r]) & 0xFFFFE000u) | (8191u - s);
            if (MODE < 4) { bool ok = true; if (SHIFT < 24) ok = (key >> ((SHIFT + 8) & 31)) == pref;
                if (ok) __hip_atomic_fetch_add(hist + 64 * ((key >> (SHIFT & 31)) & 255u), 1u, __ATOMIC_RELAXED, __HIP_MEMORY_SCOPE_WORKGROUP); }
            else if (MODE == 4) { if (key >= pref) { const unsigned pos = __hip_atomic_fetch_add(cnt, 1u, __ATOMIC_RELAXED, __HIP_MEMORY_SCOPE_WORKGROUP); sel[pos & 255u] = (unsigned short)s; } }
            else if (MODE == 5) { __hip_atomic_fetch_add(hist + 64 * mapA(key), 1u, __ATOMIC_RELAXED, __HIP_MEMORY_SCOPE_WORKGROUP); }
            else { const int dA = mapA(key);
                if (dA > (int)pref) { const unsigned pos = __hip_atomic_fetch_add(cnt, 1u, __ATOMIC_RELAXED, __HIP_MEMORY_SCOPE_WORKGROUP); sel[pos & 255u] = (unsigned short)s; }
                else if (dA == (int)pref) { const unsigned pos = __hip_atomic_fetch_add(ccnt, 1u, __ATOMIC_RELAXED, __HIP_MEMORY_SCOPE_WORKGROUP); cand[pos & (DS_CAP - 1)] = key; } } }
        a0 = n0; a1 = n1;
    }
}
template <bool FIRST> __device__ __forceinline__ void dsa_digit(LAS unsigned char* lds, int wid, int lane) {
    LAS unsigned* prefv = (LAS unsigned*)(lds + DS_PREF); LAS unsigned* remv = (LAS unsigned*)(lds + DS_REM); LAS unsigned* ceqv = (LAS unsigned*)(lds + DS_CEQ);
    for (int i = 0; i < 8; ++i) { const int ql = 8 * wid + i;
        LAS const unsigned* hp = (LAS const unsigned*)(lds + DS_HIST) + ql + 256 * lane;
        const unsigned rem = remv[ql], c0 = hp[0], c1 = hp[64], c2 = hp[128], c3 = hp[192], s = c0 + c1 + c2 + c3;
        unsigned suf = s;
#pragma unroll
        for (int o = 1; o < 64; o <<= 1) { const unsigned t = __shfl_down(suf, o); if (lane + o < 64) suf += t; }
        unsigned above = suf - s; int found = -1; unsigned nrem = 0, ceq = 0;
        if (above < rem && rem <= above + c3) { found = 3; nrem = rem - above; ceq = c3; } above += c3;
        if (above < rem && rem <= above + c2) { found = 2; nrem = rem - above; ceq = c2; } above += c2;
        if (above < rem && rem <= above + c1) { found = 1; nrem = rem - above; ceq = c1; } above += c1;
        if (above < rem && rem <= above + c0) { found = 0; nrem = rem - above; ceq = c0; }
        if (found >= 0) { prefv[ql] = FIRST ? (unsigned)(4 * lane + found) : ((prefv[ql] << 8) | (unsigned)(4 * lane + found)); remv[ql] = nrem; ceqv[ql] = ceq; } }
}
__device__ __forceinline__ void dsa_unit(const Params& p, LAS unsigned char* lds, int b, int c) {
    const int tid = threadIdx.x, lane = tid & 63, wid = rfl(tid >> 6);
    const bf16_t* Z = (const bf16_t*)(p.ws + WS_Z); bf16_t* Y = (bf16_t*)(p.ws + WS_Y);
    const size_t rowb = (size_t)b * SEQ; const bf16_t* Zb = Z + rowb * NZ;
    const int N = 64 * (c + 1), nsel = N < 256 ? N : 256, t0 = 64 * c;
    LAS unsigned short* selall = (LAS unsigned short*)(lds + DS_SEL);
    LAS unsigned* prefv = (LAS unsigned*)(lds + DS_PREF); LAS unsigned* remv = (LAS unsigned*)(lds + DS_REM); LAS unsigned* cntv = (LAS unsigned*)(lds + DS_CNT);
    LAS unsigned* ceqv = (LAS unsigned*)(lds + DS_CEQ); LAS unsigned* ccntv = (LAS unsigned*)(lds + DS_CCNT);
    if (c <= 3) { for (int i = tid; i < 64 * 256; i += 512) selall[i] = (unsigned short)(((i & 255) < N) ? (i & 255) : 0); }
    else {
        const int r32 = lane & 31, ql = 32 * (wid & 1) + r32;
        {
          const int qq = tid >> 3, ch = tid & 7;
#pragma unroll
          for (int i = 0; i < 4; ++i) { const int pc = ch + 8 * i; const u32x4 v = *(const u32x4*)(Zb + (size_t)(t0 + qq) * NZ + ZIQ + pc * 8); *(LAS u32x4*)(lds + DS_IQ + qq * 528 + pc * 16) = v; }
          ((LAS float*)(lds + DS_WQ))[ch * 64 + qq] = ((const float*)(p.ws + WS_WQ))[(rowb + t0 + qq) * 8 + ch]; }
        if (tid < 64) { prefv[tid] = 0u; remv[tid] = 256u; cntv[tid] = 0u; ccntv[tid] = 0u; }
#define DS_ZERO() do { for (int i = tid; i < 64 * 256; i += 512) ((LAS unsigned*)(lds + DS_HIST))[i] = 0u; __syncthreads(); } while (0)
        DS_ZERO();
        dsa_sweep<5>(Zb, c, wid, lane, lds, 0u); __syncthreads(); dsa_digit<true>(lds, wid, lane); __syncthreads();
        const int bad = (tid < 64) ? (ceqv[tid] > (unsigned)DS_CAP) : 0;
        int path = 0;
        if (!__syncthreads_or(bad)) { dsa_sweep<6>(Zb, c, wid, lane, lds, prefv[ql]); }
        else {
            LAS unsigned* pref1v = (LAS unsigned*)(lds + DS_PREF1);
            const unsigned dst = (tid < 64) ? prefv[tid] : 1u;
            const int sat = __syncthreads_or((dst == 0u || dst == 127u || dst == 128u || dst == 255u) ? 1 : 0);
            int bad2 = 1;
            if (!sat) {
                if (tid < 64) pref1v[tid] = dst;
                DS_ZERO();
                dsa_sweep<7>(Zb, c, wid, lane, lds, pref1v[ql]); __syncthreads(); dsa_digit<true>(lds, wid, lane); __syncthreads();
                bad2 = (tid < 64) ? (ceqv[tid] > (unsigned)DS_CAP) : 0;
                bad2 = __syncthreads_or(bad2);
            }
            if (!bad2) { dsa_sweep<8>(Zb, c, wid, lane, lds, pref1v[ql], prefv[ql]); }
            else {
                path = 2;
            if (tid < 64) { prefv[tid] = 0u; remv[tid] = 256u; }
#define DS_PASS(MD) do { DS_ZERO(); dsa_sweep<MD>(Zb, c, wid, lane, lds, prefv[ql]); __syncthreads(); dsa_digit<false>(lds, wid, lane); __syncthreads(); } while (0)
                DS_PASS(0); DS_PASS(1); DS_PASS(2); DS_PASS(3);
#undef DS_PASS
                dsa_sweep<4>(Zb, c, wid, lane, lds, prefv[ql]);

            }
        }
        __syncthreads();
        if (path != 2) {
            for (int i = 0; i < 8; ++i) { const int q2 = 8 * wid + i; const int n = (int)ceqv[q2], r = (int)remv[q2];
                LAS const unsigned* cd = (LAS const unsigned*)(lds + DS_CAND) + q2 * DS_CAP;
                unsigned kk[4]; int rank[4];
#pragma unroll
                for (int t = 0; t < 4; ++t) { kk[t] = (lane + 64 * t < n) ? cd[lane + 64 * t] : 0xFFFFFFFFu; rank[t] = 0; }
                for (int j = 0; j < n; j += 4) { u32x4 v = *(LAS const u32x4*)(cd + j);
#pragma unroll
                    for (int e = 0; e < 4; ++e) { const unsigned ve = (j + e < n) ? v[e] : 0u;
#pragma unroll
                        for (int t = 0; t < 4; ++t) rank[t] += (ve > kk[t]) ? 1 : 0; } }
#pragma unroll
                for (int t = 0; t < 4; ++t) if (lane + 64 * t < n && rank[t] < r) selall[q2 * 256 + (256 - r) + rank[t]] = (unsigned short)(8191u - (kk[t] & 0x1FFFu)); }
        }
#undef DS_ZERO
    }
    __syncthreads();
    const int n = lane & 15, g = lane >> 4, trq = (lane & 15) >> 2, trp = lane & 3;
    LAS unsigned char* vst = lds + DS_VST + wid * 8192;
#define G_KLOAD(dst, SELP, kb0, cnt) do { _Pragma("unroll") for (int i_ = 0; i_ < (cnt); ++i_) { const int s_ = (SELP)[16 * ((kb0) + i_) + n]; const bf16_t* kp_ = Zb + (size_t)s_ * NZ + ZDK + g * 8; \
        dst[2 * i_] = *(const bf16x8*)kp_; dst[2 * i_ + 1] = *(const bf16x8*)(kp_ + 32); } asm volatile("" ::: "memory"); } while (0)
#define G_S(src, kb0, cnt) do { _Pragma("unroll") for (int i_ = 0; i_ < (cnt); ++i_) { f32x4 acc_ = {0.f, 0.f, 0.f, 0.f}; acc_ = mfma16(src[2 * i_], qf0, acc_); acc_ = mfma16(src[2 * i_ + 1], qf1, acc_); sc[(kb0) + i_] = acc_; } } while (0)
#define G_VLOAD(dst, ch) do { _Pragma("unroll") for (int i_ = 0; i_ < 8; ++i_) { const int pc_ = lane + 64 * i_, rowi_ = pc_ >> 3, c16_ = pc_ & 7; const int s_ = sel[64 * (ch) + rowi_]; \
        dst[i_] = *(const u32x4*)(Zb + (size_t)s_ * NZ + ZDV + c16_ * 8); } asm volatile("" ::: "memory"); } while (0)
#define G_VSTORE(src) do { _Pragma("unroll") for (int i_ = 0; i_ < 8; ++i_) { const int pc_ = lane + 64 * i_, rowi_ = pc_ >> 3, c16_ = pc_ & 7; *(LAS u32x4*)(vst + rowi_ * 128 + c16_ * 16) = src[i_]; } \
        asm volatile("s_waitcnt lgkmcnt(0)" ::: "memory"); } while (0)
#define G_PV(ch) do { _Pragma("unroll") for (int k2 = 0; k2 < 2; ++k2) { const bf16x8 pa_ = pa[2 * (ch) + k2]; \
        _Pragma("unroll") for (int db = 0; db < 4; ++db) { LAS const unsigned char* vp = vst + (32 * k2 + 4 * g + trq) * 128 + (16 * db + 4 * trp) * 2; \
            const s16x4 lo = vtr(vp), hh = vtr(vp + 16 * 128); const bf16x8 vf = (bf16x8){lo[0], lo[1], lo[2], lo[3], hh[0], hh[1], hh[2], hh[3]}; o[db] = mfma16(pa_, vf, o[db]); } } \
        asm volatile("s_waitcnt lgkmcnt(0)" ::: "memory"); } while (0)
    bf16x8 kA[8], qfn0, qfn1;
    { LAS const unsigned short* sel0 = selall + wid * 256; G_KLOAD(kA, sel0, 0, 4);
      const bf16_t* qp = Z + (rowb + t0 + wid) * NZ + ZDQ + (n & 7) * 64 + g * 8; qfn0 = *(const bf16x8*)qp; qfn1 = *(const bf16x8*)(qp + 32); }
#pragma unroll 1
    for (int qi = 0; qi < 8; ++qi) {
        const int ql = wid + 8 * qi; const size_t row = rowb + t0 + ql;
        LAS const unsigned short* sel = selall + ql * 256;
        const bf16x8 qf0 = qfn0, qf1 = qfn1;
        bf16x8 kB[8], kC[8], kD[8]; f32x4 sc[16];
        G_KLOAD(kB, sel, 4, 4);
        G_S(kA, 0, 4);
        G_KLOAD(kC, sel, 8, 4);
        G_S(kB, 4, 4);
        G_KLOAD(kD, sel, 12, 4);
        G_S(kC, 8, 4);
        G_S(kD, 12, 4);
        u32x4 vrA[8], vrB[8];
        G_VLOAD(vrA, 0); G_VLOAD(vrB, 1);
        float mx = -INFINITY; int nlim = nsel - 4 * g; asm volatile("" : "+v"(nlim));
#pragma unroll
        for (int kb = 0; kb < 16; ++kb)
#pragma unroll
            for (int i = 0; i < 4; ++i) { if (16 * kb + i >= nlim) sc[kb][i] = -INFINITY; mx = fmaxf(mx, sc[kb][i]); }
        mx = fmaxf(mx, __shfl_xor(mx, 16)); mx = fmaxf(mx, __shfl_xor(mx, 32));
        float sum = 0.f;
#pragma unroll
        for (int kb = 0; kb < 16; ++kb)
#pragma unroll
            for (int i = 0; i < 4; ++i) { sc[kb][i] = ex2(sc[kb][i] - mx); sum += sc[kb][i]; }
        sum += __shfl_xor(sum, 16); sum += __shfl_xor(sum, 32);
        bf16x8 pa[8];
#pragma unroll
        for (int ks2 = 0; ks2 < 8; ++ks2) { u32x4 w; w.x = pg8::cvt_pk_bf16(sc[2 * ks2][0], sc[2 * ks2][1]); w.y = pg8::cvt_pk_bf16(sc[2 * ks2][2], sc[2 * ks2][3]);
            w.z = pg8::cvt_pk_bf16(sc[2 * ks2 + 1][0], sc[2 * ks2 + 1][1]); w.w = pg8::cvt_pk_bf16(sc[2 * ks2 + 1][2], sc[2 * ks2 + 1][3]); pa[ks2] = __builtin_bit_cast(bf16x8, w); }
        {
          const int qn = qi < 7 ? ql + 8 : ql; LAS const unsigned short* seln = selall + qn * 256; G_KLOAD(kA, seln, 0, 4);
          const bf16_t* qp = Z + (rowb + t0 + qn) * NZ + ZDQ + (n & 7) * 64 + g * 8; qfn0 = *(const bf16x8*)qp; qfn1 = *(const bf16x8*)(qp + 32); }
        f32x4 o[4];
#pragma unroll
        for (int db = 0; db < 4; ++db) o[db] = (f32x4){0.f, 0.f, 0.f, 0.f};
        G_VSTORE(vrA); G_VLOAD(vrA, 2); G_PV(0);
        G_VSTORE(vrB); G_VLOAD(vrB, 3); G_PV(1);
        G_VSTORE(vrA); G_PV(2);
        G_VSTORE(vrB); G_PV(3);
        float rl[4];
#pragma unroll
        for (int i = 0; i < 4; ++i) rl[i] = 1.f / __shfl(sum, (4 * g + i) & 15);
        if (g < 2) {
#pragma unroll
            for (int i = 0; i < 4; ++i)
#pragma unroll
                for (int db = 0; db < 4; ++db) Y[(size_t)MT * 512 + row * 512 + (4 * g + i) * 64 + 16 * db + n] = (bf16_t)f2bf(o[db][i] * rl[i]); }
    }
#undef G_KLOAD
#undef G_S
#undef G_VLOAD
#undef G_VSTORE
#undef G_PV
    __syncthreads();
}
__device__ __forceinline__ void phase_mixer(const Params& p, LAS unsigned char* lds) {
    const int tid = threadIdx.x, lane = tid & 63;
    const int x = blockIdx.x & 7;
    volatile LAS int* slot = (volatile LAS int*)(lds + LDS_BYTES - 128);
    {
        unsigned* q = (unsigned*)p.ws + 4096 + 64 * x;
        int nxt = 0;
        if (tid == 0) nxt = (int)__hip_atomic_fetch_add(q, 1u, __ATOMIC_RELAXED, __HIP_MEMORY_SCOPE_AGENT);
#pragma unroll 1
        for (;;) {
            if (tid == 0) slot[0] = nxt;
            __syncthreads();
            const int u = rfl(slot[0]);
            if (u >= 128) break;
            if (tid == 0) nxt = (int)__hip_atomic_fetch_add(q, 1u, __ATOMIC_RELAXED, __HIP_MEMORY_SCOPE_AGENT);
            dsa_unit(p, lds, x, 127 - u);
        }
    }
    __syncthreads();
    {
        const float mq = wave_max(fabsf(p.fox_g[lane])), mk = wave_max(fabsf(p.fox_g[64 + lane]));
        const float B2 = 8.f * mq * mk * 1.03f * LOG2E; const float thr2 = 2.f * B2 + 112.f * LOG2E;
        unsigned* q = (unsigned*)p.ws + 4096 + 64 * x + 32;
        int nxt = 0;
        if (tid == 0) nxt = (int)__hip_atomic_fetch_add(q, 1u, __ATOMIC_RELAXED, __HIP_MEMORY_SCOPE_AGENT);
#pragma unroll 1
        for (;;) {
            if (tid == 0) slot[1] = nxt;
            __syncthreads();
            const int v = rfl(slot[1]);
            if (v >= 256) break;
            if (tid == 0) nxt = (int)__hip_atomic_fetch_add(q, 1u, __ATOMIC_RELAXED, __HIP_MEMORY_SCOPE_AGENT);
            fox_unit(p, lds, v & 7, x, 31 - (v >> 3), thr2);
            __syncthreads();
        }
    }
}
#define XB_TMO      128
#define XB_XCNT(j)  (256  + 64 * (j))
#define XB_XSUB(j)  (1280 + 64 * (j))
#define XB_XGEN(j)  (2304 + 64 * (j))
#define XB_TOP      3328
#define XB_TOPGEN   3392
#define XCD_BAR_WORDS 3456
#define XB_SPIN_CAP (1u << 18)

__device__ __forceinline__ unsigned xb_ld(unsigned* p)              { return __hip_atomic_load(p, __ATOMIC_RELAXED, __HIP_MEMORY_SCOPE_AGENT); }
__device__ __forceinline__ unsigned xb_add(unsigned* p, unsigned v) { return __hip_atomic_fetch_add(p, v, __ATOMIC_RELAXED, __HIP_MEMORY_SCOPE_AGENT); }
__device__ __forceinline__ unsigned xb_xcc_id() { return (unsigned)__builtin_amdgcn_s_getreg((3 << 11) | 20) & 0xFu; }
#define XB_SPIN(cond, bar) do { unsigned _sp = 0; while (cond) { __builtin_amdgcn_s_sleep(1); \
    if ((++_sp & 255u) == 0u) { if (xb_ld(&(bar)[XB_TMO])) break; if (_sp > XB_SPIN_CAP) { atomicAdd(&(bar)[XB_TMO], 1u); break; } } } } while (0)

struct XcdBarrier {
    unsigned* bar; unsigned x;
    volatile LAS unsigned* st;
};

__device__ __forceinline__ XcdBarrier xcd_barrier_post(unsigned* bar, volatile LAS unsigned* st) {
    XcdBarrier b; b.bar = bar; b.x = xb_xcc_id(); b.st = st;
    if (threadIdx.x == 0) (void)xb_add(&bar[XB_XCNT(b.x)], 1u);
    return b;
}
__device__ __forceinline__ void xcd_barrier_complete(unsigned* bar, unsigned x, unsigned& nloc, unsigned& nx) {
    const unsigned G = gridDim.x * gridDim.y * gridDim.z;
    unsigned sum, cnt, mine, sp = 0u;
    for (;;) {
        sum = 0u; cnt = 0u; mine = 0u;
#pragma unroll
        for (unsigned j = 0; j < 16; ++j) { const unsigned c = xb_ld(&bar[XB_XCNT(j)]); sum += c; cnt += (c > 0u) ? 1u : 0u; mine = (j == x) ? c : mine; }
        if (sum == G) break;
        __builtin_amdgcn_s_sleep(1);
        if ((++sp & 255u) == 0u) { if (xb_ld(&bar[XB_TMO])) break; if (sp > XB_SPIN_CAP) { atomicAdd(&bar[XB_TMO], 1u); break; } }
    }
    nloc = mine > 0u ? mine : 1u; nx = cnt > 0u ? cnt : 1u;
}

__device__ __forceinline__ void xcd_barrier(const XcdBarrier& b) {
    asm volatile("s_waitcnt vmcnt(0)" ::: "memory");
    __syncthreads();
    if (threadIdx.x == 0) {
        unsigned* bar = b.bar;
        __builtin_amdgcn_s_waitcnt(0);
        unsigned nloc = b.st[0], nx = b.st[1];
        if (nloc == 0u) { xcd_barrier_complete(bar, b.x, nloc, nx); b.st[0] = nloc; b.st[1] = nx; }
        const unsigned old = xb_add(&bar[XB_XSUB(b.x)], 1u);
        const unsigned gen = old / nloc;
        if (old + 1u == (gen + 1u) * nloc) {
            __builtin_amdgcn_fence(__ATOMIC_RELEASE, "agent");
            asm volatile("s_waitcnt vmcnt(0)" ::: "memory");
            const unsigned og = xb_add(&bar[XB_TOP], 1u);
            const unsigned tg = og / nx;
            if (og + 1u == (tg + 1u) * nx) xb_add(&bar[XB_TOPGEN], 1u);
            else XB_SPIN(xb_ld(&bar[XB_TOPGEN]) == tg, bar);
            __builtin_amdgcn_fence(__ATOMIC_ACQUIRE, "agent");
            xb_add(&bar[XB_XGEN(b.x)], 1u);
            asm volatile("s_waitcnt vmcnt(0)" ::: "memory");
        } else {
            XB_SPIN(xb_ld(&bar[XB_XGEN(b.x)]) == gen, bar);
            __builtin_amdgcn_fence(__ATOMIC_ACQUIRE, "agent");
            asm volatile("s_waitcnt vmcnt(0)" ::: "memory");
        }
    }
    __syncthreads();
}

__global__ void __launch_bounds__(512, 2) mega(Params p) {
    extern __shared__ __attribute__((aligned(16))) unsigned char lds_raw[];
    LAS unsigned char* lds = (LAS unsigned char*)lds_raw;
    cg::grid_group grid = cg::this_grid();
    const int G = gridDim.x, bx = blockIdx.x;
    unsigned char* ws = p.ws;
    bf16_t* HN = (bf16_t*)(ws + WS_HN); bf16_t* Hh = (bf16_t*)(ws + WS_Z); bf16_t* Zz = (bf16_t*)(ws + WS_Z); bf16_t* Yy = (bf16_t*)(ws + WS_Y);
    const float* mod = (const float*)(ws + WS_MOD);
    bf16_t* X1 = (bf16_t*)p.out;
    bf16_t* X2 = (bf16_t*)(ws + WS_Y);
    unsigned* barw = (unsigned*)ws;
    volatile LAS unsigned* bst = (volatile LAS unsigned*)(lds + LDS_BYTES - 64);
    if (threadIdx.x < 2) bst[threadIdx.x] = 0u;
    if (bx == 0) for (int i = threadIdx.x; i < 4096 + 512; i += 512) __hip_atomic_store(barw + i, 0u, __ATOMIC_RELAXED, __HIP_MEMORY_SCOPE_AGENT);
    __syncthreads();
    XcdBarrier xbar; xbar.bar = barw; xbar.x = 0; xbar.st = bst;
#ifndef PMASK
#define PMASK 0xFFFF
#endif
#define PH(k) (((PMASK >> (k)) & 1) && p.ph_lo <= (k) && (k) < p.ph_hi)
#define SYNC() xcd_barrier(xbar)
#ifndef DUP_MASK
#define DUP_MASK 0
#endif
#define DUP(k)
    DUP(0) if (PH(0)) phase_prologue(p, lds);
    grid.sync();
    xbar = xcd_barrier_post(barw, bst);
    DUP(1) if (PH(1)) phase_norm(p, p.x, 0);
    SYNC();
    DUP(2) if (PH(2)) { pg8::Gemm g{HN, (const bf16_t*)(ws + WS_WUP1), MT, NUP, DM}; pg8::StaticOrder S; S.init(MT, NUP, G, bx); EpiSwiglu E{Hh};
        pg8::gemm_phase<EpiSwiglu, pg8::StaticOrder, true, true>(lds, g, S, E); }
#if (DUP_MASK >> 2) & 1
    __syncthreads(); if (PH(2)) { pg8::Gemm g{HN, (const bf16_t*)(ws + WS_WUP1), MT, NUP, DM}; pg8::StaticOrder S; S.init(MT, NUP, G, bx); EpiSwiglu E{Hh};
        pg8::gemm_phase<EpiSwiglu, pg8::StaticOrder, true, true>(lds, g, S, E); }
#endif
    SYNC();
    if (PH(3)) { pg8::Gemm g{Hh, (const bf16_t*)(ws + WS_WDN1), MT, DM, FF}; pg8::StaticOrder S; S.init(MT, DM, G, bx); EpiResidT<false, true> E{p.x, X1, mod + 2 * DM, 0.5f};
        pg8::gemm_phase<EpiResidT<false, true>, pg8::StaticOrder, true, true>(lds, g, S, E); }
    SYNC();
    if (PH(4)) phase_norm_bf(p, X1, 1);
    SYNC();
    DUP(5) if (PH(5)) { pg8::Gemm g{HN, (const bf16_t*)(ws + WS_WIN), MT, NZ, DM}; pg8::StaticOrder S; S.init(MT, NZ, G, bx); EpiZ E{Zz, (float*)(ws + WS_SIDE)};
        pg8::gemm_phase<EpiZ, pg8::StaticOrder, true, true>(lds, g, S, E); }
    SYNC();
    if (PH(6)) phase_post(p);
    SYNC();
    DUP(7) if (PH(7)) phase_cumsum(p, lds);
    SYNC();
    DUP(8) if (PH(8)) phase_mixer(p, lds);
#if (DUP_MASK >> 8) & 1
    __syncthreads(); if (PH(8)) phase_mixer<1>(p, lds);
#endif
    SYNC();
    if (PH(9)) {
        { pg8::Gemm g{Yy, (const bf16_t*)(ws + WS_WA), MT, DM, 512}; pg8::StaticOrder S; S.init(MT, DM, G, bx); EpiGate<false> E{HN, Zz + ZGA};
          pg8::gemm_phase<EpiGate<false>, pg8::StaticOrder, true, true>(lds, g, S, E); }
        { pg8::Gemm g{Yy + (size_t)MT * 512, (const bf16_t*)(ws + WS_WB), MT, DM, 512}; pg8::StaticOrder S; S.init(MT, DM, G, bx); EpiGate<true> E{HN, Zz + ZGB};
          pg8::gemm_phase<EpiGate<true>, pg8::StaticOrder, true, true>(lds, g, S, E); } }
    SYNC();
    if (PH(10)) { pg8::Gemm g{HN, (const bf16_t*)(ws + WS_WO), MT, DM, DM}; pg8::StaticOrder S; S.init(MT, DM, G, bx); EpiResidT<true, true> E{X1, X2, mod + 5 * DM, 1.0f};
        pg8::gemm_phase<EpiResidT<true, true>, pg8::StaticOrder, true, true>(lds, g, S, E); }
    SYNC();
    if (PH(11)) phase_norm_bf(p, X2, 2);
    SYNC();
    if (PH(12)) { pg8::Gemm g{HN, (const bf16_t*)(ws + WS_WUP2), MT, NUP, DM}; pg8::StaticOrder S; S.init(MT, NUP, G, bx); EpiSwiglu E{Hh};
        pg8::gemm_phase<EpiSwiglu, pg8::StaticOrder, true, true>(lds, g, S, E); }
    SYNC();
    if (PH(13)) { pg8::Gemm g{Hh, (const bf16_t*)(ws + WS_WDN2), MT, DM, FF}; pg8::StaticOrder S; S.init(MT, DM, G, bx); EpiResidT<true, false> E{X2, p.out, mod + 8 * DM, 0.5f};
        pg8::gemm_phase<EpiResidT<true, false>, pg8::StaticOrder, true, true>(lds, g, S, E); }
#if (DUP_MASK >> 16) & 1
    for (int i_ = 0; i_ < 16; ++i_) SYNC();
#endif
#undef PH
#undef SYNC
}

extern "C" void kernel_launch(void* const* d_in, const int* in_sizes, int n_in, void* d_out, int out_size, void* d_ws, size_t ws_size, hipStream_t stream) {
    static int grid = 0;
    if (grid == 0) {
        if (n_in != 19 || out_size != MT * DM || ws_size < WS_END) { fprintf(stderr, "kernel_launch: unexpected shapes (n_in %d out %d ws %zu)\n", n_in, out_size, ws_size); grid = -1; return; }
        int dev = 0, cus = 0, per_cu = 0;
        hipGetDevice(&dev); hipDeviceGetAttribute(&cus, hipDeviceAttributeMultiprocessorCount, dev);
        if (hipFuncSetAttribute((const void*)mega, hipFuncAttributeMaxDynamicSharedMemorySize, LDS_BYTES) != hipSuccess) { fprintf(stderr, "kernel_launch: hipFuncSetAttribute failed\n"); grid = -1; return; }
        if (hipOccupancyMaxActiveBlocksPerMultiprocessor(&per_cu, (const void*)mega, 512, LDS_BYTES) != hipSuccess || per_cu < 1) { fprintf(stderr, "kernel_launch: occupancy query says %d\n", per_cu); per_cu = 1; }
        (void)hipGetLastError();
        grid = cus;
    }
    if (grid < 0) return;
    Params p{};
    p.x = (const float*)d_in[0]; p.c = (const float*)d_in[1]; p.pos = (const int*)d_in[2]; p.ada_w = (const float*)d_in[3]; p.ada_b = (const float*)d_in[4]; p.norm_g = (const float*)d_in[5];
    p.f1w1 = (const float*)d_in[6]; p.f1w3 = (const float*)d_in[7]; p.f1w2 = (const float*)d_in[8]; p.w_in = (const float*)d_in[9]; p.fbias = (const float*)d_in[10]; p.fox_g = (const float*)d_in[11];
    p.dsa_g = (const float*)d_in[12]; p.wbf = (const float*)d_in[13]; p.wbd = (const float*)d_in[14]; p.wout = (const float*)d_in[15]; p.f2w1 = (const float*)d_in[16]; p.f2w3 = (const float*)d_in[17]; p.f2w2 = (const float*)d_in[18];
    p.out = (float*)d_out; p.ws = (unsigned char*)d_ws;
    for (int i = 0; i < 8; ++i) p.invfA[i] = (float)pow(500000.0, -(double)(2 * i) / 16.0);
    for (int i = 0; i < 4; ++i) p.invfI[i] = (float)pow(500000.0, -(double)(2 * i) / 8.0);
    p.ph_lo = 0; p.ph_hi = 100;
    void* args[] = {&p};
    hipError_t e = hipLaunchCooperativeKernel((const void*)mega, dim3(grid), dim3(512), args, LDS_BYTES, stream);
    if (e != hipSuccess) fprintf(stderr, "kernel_launch: cooperative launch failed: %s (grid %d)\n", hipGetErrorString(e), grid);
}
```

```cpp
#include <hip/hip_runtime.h>
#include <hip/hip_cooperative_groups.h>
#include <cstdio>
#include <cstdint>
#include <cmath>
namespace cg = cooperative_groups;
namespace pg8 {
#define PG8_LAS __attribute__((address_space(3)))
typedef unsigned short bf16_t;
typedef short bf16x8 __attribute__((ext_vector_type(8)));
typedef float f32x4 __attribute__((ext_vector_type(4)));
typedef unsigned u32x4 __attribute__((ext_vector_type(4)));
constexpr int BM = 256, BK = 64, HALF = 128, HTB = HALF * BK * 2  , STAGE_BYTES = 8 * HTB, NXCD = 8, WGM = 8;

__host__ __device__ __forceinline__ int lds_byte(int r, int c) { const int st = (r >> 4) * 2 + (c >> 5), rr = r & 15, cc = c & 31, ob = rr * 64 + cc * 2; return st * 1024 + (ob ^ (((ob >> 9) & 1) << 5)); }
__host__ __device__ __forceinline__ void stage_rc(int b, int& R, int& C) { const int st = b / 1024, sb = b % 1024, swz = sb ^ (((sb >> 9) & 1) << 5); R = (st >> 1) * 16 + swz / 64; C = (st & 1) * 32 + (swz % 64) / 2; }
__host__ __device__ __forceinline__ int perm32(int rho) { const int n = rho >> 4, i = rho & 15; return 8 * (i >> 2) + 4 * n + (i & 3); }

struct Unit { int pm, pn; };
struct Gemm { const bf16_t* A; const bf16_t* Bt; int M, N, K; };

struct StaticOrder {
    int nM, nN, nwg, G, c;
    __host__ __device__ void init(int M, int N, int G_, int c_) { nM = M / BM; nN = N / BM; nwg = nM * nN; G = G_; c = c_; }
    __host__ __device__ bool next(int i, Unit& u) const {
        const long L = (long)i * G + c; if (L >= nwg) return false;
        int wgid = (int)L; { const int q = nwg / NXCD, r = nwg % NXCD, xcd = wgid % NXCD, off = wgid / NXCD; wgid = (xcd < r ? xcd * (q + 1) : r * (q + 1) + (xcd - r) * q) + off; }
        const int nig = WGM * nN, gid = wgid / nig, fm = gid * WGM, gsz = (nM - fm) < WGM ? (nM - fm) : WGM;
        u.pm = fm + ((wgid % nig) % gsz); u.pn = (wgid % nig) / gsz; return true;
    }
    __device__ __forceinline__ void a_ready(const Unit&) const {}
    __device__ __forceinline__ void done(const Unit&) const {}
};

__device__ __forceinline__ unsigned cvt_pk_bf16(float lo, float hi) { unsigned r; asm volatile("v_cvt_pk_bf16_f32 %0, %1, %2" : "=v"(r) : "v"(lo), "v"(hi)); return r; }
typedef float f32x2 __attribute__((ext_vector_type(2)));
__device__ __forceinline__ f32x2 gelu_pk(f32x2 v) {
    const f32x2 av = __builtin_elementwise_abs(v), d = av * 0.2316418882f + 1.0f;
    f32x2 t; t.x = __builtin_amdgcn_rcpf(d.x); t.y = __builtin_amdgcn_rcpf(d.y);
    f32x2 q = t * 0.5307027145f + (-0.7265760135f); q = q * t + 0.7107068705f; q = q * t + (-0.142248368f); q = q * t + 0.127414796f; q = q * t;
    const f32x2 s = (v * v) * (-0.72134752044f);
    f32x2 e; e.x = __builtin_amdgcn_exp2f(s.x); e.y = __builtin_amdgcn_exp2f(s.y);
    const f32x2 m = v * (q * e), r = v - m;
    f32x2 o; o.x = v.x < 0.f ? m.x : r.x; o.y = v.y < 0.f ? m.y : r.y; return o;
}

template <int ACT  > struct EpiBf16 {
    static constexpr bool PERM = true, AFTER_DRAIN = false; static_assert(ACT == 0 || ACT == 1, "EpiBf16: ACT is 0 (none) or 1 (gelu_pk)");
    bf16_t* O; int ldc; const float* bias; int split_cols; size_t split_stride; float scale0;
    __device__ __forceinline__ void operator()(const f32x4 (&acc)[2][2][4][2], const Unit& u, int wr, int wc, int fr, int fq) const {
        const int row0 = u.pm * BM + wr * 64 + fr; int colt = u.pn * BM; bf16_t* base = O;
        float sc = 1.f; if (split_cols) { const int t = colt / split_cols; base += (size_t)t * split_stride; colt -= t * split_cols; if (t == 0) sc = scale0; }
        const int col0 = colt + wc * 32 + 8 * fq, bcol0 = u.pn * BM + wc * 32 + 8 * fq;
        f32x4 bv[2][2];
#pragma unroll
        for (int bj = 0; bj < 2; ++bj)
#pragma unroll
            for (int n = 0; n < 2; ++n) bv[bj][n] = bias ? *(const f32x4*)(bias + bcol0 + bj * HALF + 4 * n) : (f32x4){0.f, 0.f, 0.f, 0.f};
#pragma unroll
        for (int ai = 0; ai < 2; ++ai)
#pragma unroll
            for (int m = 0; m < 4; ++m) { bf16_t* rowp = base + (size_t)(row0 + ai * HALF + m * 16) * ldc + col0;
#pragma unroll
                for (int bj = 0; bj < 2; ++bj) { f32x4 v0 = acc[ai][bj][m][0] + bv[bj][0], v1 = acc[ai][bj][m][1] + bv[bj][1];
                    if (ACT == 1) { f32x2 a = gelu_pk((f32x2){v0[0], v0[1]}), b = gelu_pk((f32x2){v0[2], v0[3]}), c = gelu_pk((f32x2){v1[0], v1[1]}), d = gelu_pk((f32x2){v1[2], v1[3]});
                        v0 = (f32x4){a.x, a.y, b.x, b.y}; v1 = (f32x4){c.x, c.y, d.x, d.y}; }
                    v0 = v0 * sc; v1 = v1 * sc; u32x4 w; w.x = cvt_pk_bf16(v0[0], v0[1]); w.y = cvt_pk_bf16(v0[2], v0[3]); w.z = cvt_pk_bf16(v1[0], v1[1]); w.w = cvt_pk_bf16(v1[2], v1[3]);
                    *(u32x4*)(rowp + bj * HALF) = w; } }
    }
};
template <class Epi, class Sched, bool ALIGN_EPI = false, bool SP2 = false>
__device__ __forceinline__ void gemm_phase(PG8_LAS unsigned char* lds, const Gemm g, const Sched& S, const Epi& E) {
    const int tid = threadIdx.x, wid = __builtin_amdgcn_readfirstlane(tid >> 6), lane = tid & 63, wr = wid >> 2, wc = wid & 3, fr = lane & 15, fq = lane >> 4;
    const int K = g.K, nt = K / BK;
    unsigned voffA[2], voffB[2];
#pragma unroll
    for (int i = 0; i < 2; ++i) { int R, C; stage_rc(tid * 16 + i * 8192, R, C); const int Rb = Epi::PERM ? ((R & ~31) + perm32(R & 31)) : R;
        voffA[i] = (unsigned)(R * K + C) * 2u; voffB[i] = (unsigned)(Rb * K + C) * 2u; }
    const size_t kstep = (size_t)(BK * 2);
    const size_t hstep = (size_t)HALF * K * 2;
    const size_t tstep = 2 * hstep;
    const unsigned ldsw = (unsigned)wid * 1024u;
    const int aoff = lds_byte(wr * 64 + fr, fq * 8), boff = lds_byte(wc * 32 + fr, fq * 8);
#define PG8_SA(b, h) (((b) * 2 + (h)) * HTB)
#define PG8_SB(b, h) ((4 + (b) * 2 + (h)) * HTB)
#define PG8_STAGE(bufoff, gbase, voff) do { _Pragma("unroll") for (int _i = 0; _i < 2; ++_i) \
        __builtin_amdgcn_global_load_lds((const unsigned*)((const char*)(gbase) + (voff)[_i]), (PG8_LAS unsigned*)(lds + (bufoff) + ldsw + _i * 8192), 16, 0, 0); } while (0)
#define PG8_LDA(dst, b, h) do { _Pragma("unroll") for (int m = 0; m < 4; ++m) _Pragma("unroll") for (int k = 0; k < 2; ++k) dst[m][k] = *(const PG8_LAS bf16x8*)(lds + PG8_SA(b, h) + aoff + m * 2048 + k * 1024); } while (0)
#define PG8_LDB(dst, b, h) do { _Pragma("unroll") for (int n = 0; n < 2; ++n) _Pragma("unroll") for (int k = 0; k < 2; ++k) dst[n][k] = *(const PG8_LAS bf16x8*)(lds + PG8_SB(b, h) + boff + n * 2048 + k * 1024); } while (0)
#define PG8_MMA(ai, bj, At, Bt) do { __builtin_amdgcn_s_setprio(1); _Pragma("unroll") for (int m = 0; m < 4; ++m) _Pragma("unroll") for (int n = 0; n < 2; ++n) _Pragma("unroll") for (int k = 0; k < 2; ++k) \
        acc[ai][bj][m][n] = __builtin_amdgcn_mfma_f32_16x16x32_bf16(Bt[n][k], At[m][k], acc[ai][bj][m][n], 0, 0, 0); __builtin_amdgcn_s_setprio(0); } while (0)
#define PG8_WAIT_V(n) asm volatile("s_waitcnt vmcnt(" #n ")" ::: "memory")
#define PG8_WAIT_L(n) asm volatile("s_waitcnt lgkmcnt(" #n ")" ::: "memory")
#define PG8_BAR __builtin_amdgcn_s_barrier()
#define PG8_SCHED __builtin_amdgcn_sched_barrier(0)
    Unit cur, nxt; int ui = 0;
    if (!S.next(0, cur)) return;
    f32x4 acc[2][2][4][2];
#pragma unroll
    for (int a = 0; a < 2; ++a)
#pragma unroll
        for (int b = 0; b < 2; ++b)
#pragma unroll
            for (int m = 0; m < 4; ++m)
#pragma unroll
                for (int n = 0; n < 2; ++n) acc[a][b][m][n] = (f32x4){0.f, 0.f, 0.f, 0.f};
    bf16x8 At[4][2], B0[2][2], B1[2][2];
    const char* cA = (const char*)g.A + (size_t)cur.pm * tstep; const char* cB = (const char*)g.Bt + (size_t)cur.pn * tstep;
    S.a_ready(cur);
    if constexpr (SP2) {
        PG8_STAGE(PG8_SB(0, 0), cB, voffB); PG8_STAGE(PG8_SB(0, 1), cB + hstep, voffB); PG8_STAGE(PG8_SA(0, 0), cA, voffA); PG8_STAGE(PG8_SA(0, 1), cA + hstep, voffA);
        if (wr == 1) PG8_BAR;
        PG8_WAIT_V(2); PG8_BAR;
        PG8_STAGE(PG8_SB(1, 0), cB + kstep, voffB); PG8_STAGE(PG8_SA(1, 0), cA + kstep, voffA); PG8_STAGE(PG8_SB(1, 1), cB + hstep + kstep, voffB);
        PG8_WAIT_V(6); PG8_BAR;
    } else {
        PG8_STAGE(PG8_SB(0, 0), cB, voffB); PG8_STAGE(PG8_SA(0, 0), cA, voffA); PG8_STAGE(PG8_SB(0, 1), cB + hstep, voffB); PG8_STAGE(PG8_SA(0, 1), cA + hstep, voffA);
        if (wr == 1) PG8_BAR;
        PG8_WAIT_V(4); PG8_BAR;
        PG8_STAGE(PG8_SB(1, 0), cB + kstep, voffB); PG8_STAGE(PG8_SA(1, 0), cA + kstep, voffA); PG8_STAGE(PG8_SB(1, 1), cB + hstep + kstep, voffB);
        PG8_WAIT_V(6); PG8_BAR;
    }
    for (;;) {
        const bool has_next = S.next(ui + 1, nxt);
        const char* nA = has_next ? (const char*)g.A + (size_t)nxt.pm * tstep : cA; const char* nB = has_next ? (const char*)g.Bt + (size_t)nxt.pn * tstep : cB;
        for (int t = 0; t < nt; t += 2) {
            const bool last = (t == nt - 2);
            const char* a1 = cA + (size_t)(t + 1) * kstep;
            const char* a2 = last ? nA : cA + (size_t)(t + 2) * kstep; const char* b2 = last ? nB : cB + (size_t)(t + 2) * kstep;
            const char* a3 = a2 + kstep; const char* b3 = b2 + kstep;
            if (last && has_next) S.a_ready(nxt);
            if constexpr (SP2) {
            PG8_LDB(B0, 0, 0); PG8_LDB(B1, 0, 1); PG8_SCHED; PG8_LDA(At, 0, 0); PG8_STAGE(PG8_SA(1, 1), a1 + hstep, voffA);
            PG8_WAIT_V(8); PG8_WAIT_L(0); PG8_BAR; PG8_MMA(0, 0, At, B0); PG8_MMA(0, 1, At, B1); PG8_BAR; PG8_SCHED;
            PG8_LDA(At, 0, 1); PG8_STAGE(PG8_SB(0, 0), b2, voffB); PG8_STAGE(PG8_SB(0, 1), b2 + hstep, voffB); PG8_STAGE(PG8_SA(0, 0), a2, voffA);
            PG8_WAIT_V(8); PG8_WAIT_L(0); PG8_BAR; PG8_MMA(1, 0, At, B0); PG8_MMA(1, 1, At, B1); PG8_BAR; PG8_SCHED;
            PG8_LDB(B0, 1, 0); PG8_LDB(B1, 1, 1); PG8_SCHED; PG8_LDA(At, 1, 0); PG8_STAGE(PG8_SA(0, 1), a2 + hstep, voffA);
            PG8_WAIT_V(8); PG8_WAIT_L(0); PG8_BAR; PG8_MMA(0, 0, At, B0); PG8_MMA(0, 1, At, B1); PG8_BAR; PG8_SCHED;
            PG8_LDA(At, 1, 1); PG8_STAGE(PG8_SB(1, 0), b3, voffB); PG8_STAGE(PG8_SB(1, 1), b3 + hstep, voffB); PG8_STAGE(PG8_SA(1, 0), a3, voffA);
            PG8_WAIT_V(8); PG8_WAIT_L(0); PG8_BAR; PG8_MMA(1, 0, At, B0); PG8_MMA(1, 1, At, B1); PG8_BAR; PG8_SCHED;
            } else {
            PG8_LDB(B0, 0, 0); PG8_SCHED; PG8_LDA(At, 0, 0); PG8_STAGE(PG8_SA(1, 1), a1 + hstep, voffA);
            PG8_WAIT_L(8); PG8_BAR; PG8_WAIT_L(0); PG8_MMA(0, 0, At, B0); PG8_BAR; PG8_SCHED;
            PG8_LDB(B1, 0, 1); PG8_STAGE(PG8_SB(0, 0), b2, voffB);
            PG8_BAR; PG8_WAIT_L(0); PG8_MMA(0, 1, At, B1); PG8_BAR;
            PG8_LDA(At, 0, 1); PG8_STAGE(PG8_SA(0, 0), a2, voffA);
            PG8_BAR; PG8_WAIT_L(0); PG8_MMA(1, 0, At, B0); PG8_BAR; PG8_SCHED;
            PG8_STAGE(PG8_SB(0, 1), b2 + hstep, voffB);
            PG8_WAIT_V(6); PG8_BAR; PG8_MMA(1, 1, At, B1); PG8_BAR;
            PG8_LDB(B0, 1, 0); PG8_SCHED; PG8_LDA(At, 1, 0); PG8_STAGE(PG8_SA(0, 1), a2 + hstep, voffA);
            PG8_WAIT_L(8); PG8_BAR; PG8_WAIT_L(0); PG8_MMA(0, 0, At, B0); PG8_BAR; PG8_SCHED;
            PG8_LDB(B1, 1, 1); PG8_STAGE(PG8_SB(1, 0), b3, voffB);
            PG8_BAR; PG8_WAIT_L(0); PG8_MMA(0, 1, At, B1); PG8_BAR;
            PG8_LDA(At, 1, 1); PG8_STAGE(PG8_SA(1, 0), a3, voffA);
            PG8_BAR; PG8_WAIT_L(0); PG8_MMA(1, 0, At, B0); PG8_BAR; PG8_SCHED;
            PG8_STAGE(PG8_SB(1, 1), b3 + hstep, voffB);
            PG8_WAIT_V(6); PG8_BAR; PG8_MMA(1, 1, At, B1); PG8_BAR;
            }
        }
        if constexpr (ALIGN_EPI) { if (wr == 0) PG8_BAR; }
        if constexpr (!Epi::AFTER_DRAIN) { E(acc, cur, wr, wc, fr, fq); S.done(cur); }
        if (!has_next) break;
#pragma unroll
        for (int a = 0; a < 2; ++a)
#pragma unroll
            for (int b = 0; b < 2; ++b)
#pragma unroll
                for (int m = 0; m < 4; ++m)
#pragma unroll
                    for (int n = 0; n < 2; ++n) acc[a][b][m][n] = (f32x4){0.f, 0.f, 0.f, 0.f};
        cur = nxt; cA = nA; cB = nB; ++ui;
        if constexpr (ALIGN_EPI) { if (wr == 1) PG8_BAR; }
    }
    PG8_WAIT_V(0);
    if constexpr (!ALIGN_EPI) { if (wr == 0) PG8_BAR; }
    PG8_BAR;
    if constexpr (Epi::AFTER_DRAIN) { E.fused(acc, cur, wr, wc, fr, fq, lds, wid, lane); S.done(cur); }
#undef PG8_SA
#undef PG8_SB
#undef PG8_STAGE
#undef PG8_LDA
#undef PG8_LDB
#undef PG8_MMA
#undef PG8_WAIT_V
#undef PG8_WAIT_L
#undef PG8_BAR
#undef PG8_SCHED
}
}

#define LAS __attribute__((address_space(3)))
typedef unsigned short bf16_t;
typedef short bf16x8 __attribute__((ext_vector_type(8)));
typedef float f32x4 __attribute__((ext_vector_type(4)));
typedef float f32x16 __attribute__((ext_vector_type(16)));
typedef unsigned u32x4 __attribute__((ext_vector_type(4)));
typedef unsigned u32x2 __attribute__((ext_vector_type(2)));
typedef short s16x4 __attribute__((ext_vector_type(4)));

constexpr int NB = 8, SEQ = 8192, DM = 1024, MT = NB * SEQ, FF = 2816, NZ = 4608, NUP = 2 * FF, NMOD = 9216;
constexpr int ZQ = 0, ZK = 512, ZV = 1024, ZDQ = 1536, ZDK = 2048, ZDV = 2112, ZIQ = 2176, ZIK = 2432, ZFF = 2464, ZIW = 2472, ZGA = 2560, ZGB = 3584;
constexpr float LOG2E = 1.4426950408889634f;
constexpr float C2 = 0.125f * LOG2E;
constexpr size_t MiB = 1u << 20;
constexpr size_t WS_MOD = 1 * MiB, WS_SIDE = 2 * MiB, WS_F2 = 6 * MiB, WS_LF = 8 * MiB, WS_WQ = 10 * MiB;
constexpr size_t WS_WUP1 = 12 * MiB, WS_WDN1 = 24 * MiB, WS_WUP2 = 30 * MiB, WS_WDN2 = 42 * MiB, WS_WIN = 48 * MiB, WS_WA = 58 * MiB, WS_WB = 59 * MiB, WS_WO = 60 * MiB;
constexpr size_t WS_HN = 64 * MiB, WS_Y = 192 * MiB, WS_Z = 320 * MiB, WS_END = 896 * MiB;
constexpr int LDS_BYTES = 147456;

struct Params {
    const float *x, *c; const int* pos; const float *ada_w, *ada_b, *norm_g, *f1w1, *f1w3, *f1w2, *w_in, *fbias, *fox_g, *dsa_g, *wbf, *wbd, *wout, *f2w1, *f2w3, *f2w2;
    float* out; unsigned char* ws;
    float invfA[8]; float invfI[4];
    int ph_lo, ph_hi;
};

__device__ __forceinline__ int rfl(int v) { return __builtin_amdgcn_readfirstlane(v); }
__device__ __forceinline__ float bf2f(unsigned v) { return __uint_as_float(v << 16); }
__device__ __forceinline__ unsigned f2bf(float f) { unsigned u = __float_as_uint(f); return (u + 0x7fffu + ((u >> 16) & 1u)) >> 16; }
__device__ __forceinline__ unsigned pk2(float lo, float hi) { return f2bf(lo) | (f2bf(hi) << 16); }
__device__ __forceinline__ float wave_sum(float v) {
#pragma unroll
    for (int o = 1; o < 64; o <<= 1) v += __shfl_xor(v, o);
    return v;
}
__device__ __forceinline__ float wave_max(float v) {
#pragma unroll
    for (int o = 1; o < 64; o <<= 1) v = fmaxf(v, __shfl_xor(v, o));
    return v;
}
__device__ __forceinline__ float ex2(float v) { return __builtin_amdgcn_exp2f(v); }
__device__ __forceinline__ float sigmoidf_(float v) { return __builtin_amdgcn_rcpf(1.f + ex2(-v * LOG2E)); }
__device__ __forceinline__ int crow(int r, int hi) { return (r & 3) + 8 * (r >> 2) + 4 * hi; }

struct ColPlain { const float* W; int ld; __device__ __forceinline__ const float* ptr(int n) const { return W + n; } };
struct ColUp { const float* W1; const float* W3; int ld; __device__ __forceinline__ const float* ptr(int n) const { const int t = n >> 8, r = n & 255; const long long dlt = (r < 128) ? 0ll : (long long)(W3 - W1); return W1 + dlt + t * 128 + (r & 127); } };
struct ColWin { const float* W; int ld;
    __device__ __forceinline__ const float* ptr(int n) const {
        int s;
        if (n < 1536) s = n; else if (n < 2048) s = 1544 + (n - 1536); else if (n < 2112) s = 2056 + (n - 2048); else if (n < 2176) s = 2120 + (n - 2112);
        else if (n < 2432) s = 2184 + (n - 2176); else if (n < 2464) s = 2440 + (n - 2432); else if (n < 2472) s = 1536 + (n - 2464); else if (n < 2480) s = n;
        else if (n < 2560) s = -1; else if (n < 3584) s = 2480 + (n - 2560); else s = 3504 + (n - 3584);
        return s < 0 ? nullptr : W + s; } };
template <class CF> __device__ __forceinline__ void transpose_item(const CF& cf, int K, bf16_t* WT, LAS float* scr, int item, int nblk, int lane) {
    const int kb = item / nblk, nb = item % nblk, k0 = 64 * kb, n0 = 32 * nb;
    const float* cp = cf.ptr(n0 + (lane & 31));
#pragma unroll 1
    for (int h2 = 0; h2 < 2; ++h2) { float tv[16];
        const float* cq = cp ? cp + (size_t)(k0 + 32 * h2 + (lane >> 5)) * cf.ld : nullptr;
#pragma unroll
        for (int i = 0; i < 16; ++i) tv[i] = cq ? cq[(size_t)(2 * i) * cf.ld] : 0.f;
#pragma unroll
        for (int i = 0; i < 16; ++i) scr[(32 * h2 + 2 * i + (lane >> 5)) * 33 + (lane & 31)] = tv[i]; }
    asm volatile("s_waitcnt lgkmcnt(0)" ::: "memory");
    const int c = lane & 7;
#pragma unroll
    for (int j = 0; j < 4; ++j) { const int n = (lane >> 3) + 8 * j; const LAS float* s = scr + (8 * c) * 33 + n;
        u32x4 o; o.x = pk2(s[0 * 33], s[1 * 33]); o.y = pk2(s[2 * 33], s[3 * 33]); o.z = pk2(s[4 * 33], s[5 * 33]); o.w = pk2(s[6 * 33], s[7 * 33]);
        *(u32x4*)(WT + (size_t)(n0 + n) * K + k0 + 8 * c) = o; }
    asm volatile("s_waitcnt lgkmcnt(0)" ::: "memory");
}
__device__ __forceinline__ void phase_prologue(const Params& p, LAS unsigned char* lds) {
    const int tid = threadIdx.x, lane = tid & 63, wid = rfl(tid >> 6);
    float* mod = (float*)(p.ws + WS_MOD);
    if (blockIdx.x < NMOD / 64) {
        LAS float* sc = (LAS float*)lds;
        LAS float* red = (LAS float*)(lds + 32768);
        for (int i = tid; i < NB * DM; i += 512) { const float v = p.c[i]; sc[i] = v / (1.f + __expf(-v)); }
        __syncthreads();
        const int col = blockIdx.x * 64 + lane;
        float acc[NB];
#pragma unroll
        for (int b = 0; b < NB; ++b) acc[b] = 0.f;
#pragma unroll 16
        for (int k = wid; k < DM; k += 8) { const float w = p.ada_w[(size_t)k * NMOD + col];
#pragma unroll
            for (int b = 0; b < NB; ++b) acc[b] = fmaf(sc[b * DM + k], w, acc[b]); }
#pragma unroll
        for (int b = 0; b < NB; ++b) red[(wid * 8 + b) * 64 + lane] = acc[b];
        __syncthreads();
        { const int b = wid; float s = p.ada_b[col];
#pragma unroll
          for (int w = 0; w < 8; ++w) s += red[(w * 8 + b) * 64 + lane];
          mod[b * NMOD + col] = s; }
        __syncthreads();
    }
    LAS float* scr = (LAS float*)(lds + wid * 16384);
    const int gw = blockIdx.x * 8 + wid, NGW = gridDim.x * 8;
    constexpr int I_UP = (DM / 64) * (NUP / 32), I_DN = (FF / 64) * (DM / 32), I_IN = (DM / 64) * (NZ / 32), I_BR = (512 / 64) * (DM / 32), I_O = (DM / 64) * (DM / 32);
    constexpr int NITEMS = 2 * I_UP + 2 * I_DN + I_IN + 2 * I_BR + I_O;
    for (int it = gw; it < NITEMS; it += NGW) {
        int r = it;
        if (r < I_UP) { transpose_item(ColUp{p.f1w1, p.f1w3, FF}, DM, (bf16_t*)(p.ws + WS_WUP1), scr, r, NUP / 32, lane); continue; } r -= I_UP;
        if (r < I_UP) { transpose_item(ColUp{p.f2w1, p.f2w3, FF}, DM, (bf16_t*)(p.ws + WS_WUP2), scr, r, NUP / 32, lane); continue; } r -= I_UP;
        if (r < I_DN) { transpose_item(ColPlain{p.f1w2, DM}, FF, (bf16_t*)(p.ws + WS_WDN1), scr, r, DM / 32, lane); continue; } r -= I_DN;
        if (r < I_DN) { transpose_item(ColPlain{p.f2w2, DM}, FF, (bf16_t*)(p.ws + WS_WDN2), scr, r, DM / 32, lane); continue; } r -= I_DN;
        if (r < I_IN) { transpose_item(ColWin{p.w_in, 4528}, DM, (bf16_t*)(p.ws + WS_WIN), scr, r, NZ / 32, lane); continue; } r -= I_IN;
        if (r < I_BR) { transpose_item(ColPlain{p.wbf, DM}, 512, (bf16_t*)(p.ws + WS_WA), scr, r, DM / 32, lane); continue; } r -= I_BR;
        if (r < I_BR) { transpose_item(ColPlain{p.wbd, DM}, 512, (bf16_t*)(p.ws + WS_WB), scr, r, DM / 32, lane); continue; } r -= I_BR;
        transpose_item(ColPlain{p.wout, DM}, DM, (bf16_t*)(p.ws + WS_WO), scr, r, DM / 32, lane);
    }
}

__device__ __forceinline__ void phase_norm(const Params& p, const float* src, int sub) {
    const int tid = threadIdx.x, lane = tid & 63, wid = rfl(tid >> 6);
    const int gw = blockIdx.x * 8 + wid, NGW = gridDim.x * 8;
    const float* mod = (const float*)(p.ws + WS_MOD);
    bf16_t* HN = (bf16_t*)(p.ws + WS_HN);
    const float* g = p.norm_g + sub * DM;
    f32x4 gv[4];
#pragma unroll
    for (int j = 0; j < 4; ++j) gv[j] = *(const f32x4*)(g + 256 * j + 4 * lane);
    for (int m0 = gw; m0 < MT; m0 += 2 * NGW) {
        f32x4 v[2][4]; float ss[2];
#pragma unroll
        for (int t = 0; t < 2; ++t) { const int m = m0 + t * NGW; const f32x4* xr = (const f32x4*)(src + (size_t)(m < MT ? m : m0) * DM) + lane; float s = 0.f;
#pragma unroll
            for (int j = 0; j < 4; ++j) { v[t][j] = xr[64 * j]; }
#pragma unroll
            for (int j = 0; j < 4; ++j) s += (v[t][j].x * v[t][j].x + v[t][j].y * v[t][j].y) + (v[t][j].z * v[t][j].z + v[t][j].w * v[t][j].w);
            ss[t] = s; }
#pragma unroll
        for (int t = 0; t < 2; ++t) { const int m = m0 + t * NGW; if (m >= MT) break; const int b = m >> 13;
            const float* sh = mod + b * NMOD + (3 * sub + 0) * DM, *scl = mod + b * NMOD + (3 * sub + 1) * DM;
            const float rstd = 1.f / sqrtf(wave_sum(ss[t]) * (1.f / DM) + 1e-6f);
            u32x2* o8 = (u32x2*)(HN + (size_t)m * DM) + lane;
#pragma unroll
            for (int j = 0; j < 4; ++j) { const f32x4 sv = *(const f32x4*)(scl + 256 * j + 4 * lane), hv = *(const f32x4*)(sh + 256 * j + 4 * lane);
                const f32x4 y = (v[t][j] * rstd) * gv[j] * (sv + 1.f) + hv;
                u32x2 w; w.x = pk2(y.x, y.y); w.y = pk2(y.z, y.w); o8[64 * j] = w; } }
    }
}

__device__ __forceinline__ void phase_norm_bf(const Params& p, const bf16_t* src, int sub) {
    const int tid = threadIdx.x, lane = tid & 63, wid = rfl(tid >> 6);
    const int gw = blockIdx.x * 8 + wid, NGW = gridDim.x * 8;
    const float* mod = (const float*)(p.ws + WS_MOD);
    bf16_t* HN = (bf16_t*)(p.ws + WS_HN);
    const float* g = p.norm_g + sub * DM;
    float gf[2][8];
#pragma unroll
    for (int j = 0; j < 2; ++j) { const f32x4 ga = *(const f32x4*)(g + 512 * j + 8 * lane), gb = *(const f32x4*)(g + 512 * j + 8 * lane + 4);
        gf[j][0] = ga.x; gf[j][1] = ga.y; gf[j][2] = ga.z; gf[j][3] = ga.w; gf[j][4] = gb.x; gf[j][5] = gb.y; gf[j][6] = gb.z; gf[j][7] = gb.w; }
    constexpr int RIF = 4;
    for (int m0 = gw; m0 < MT; m0 += RIF * NGW) {
        u32x4 r[RIF][2]; float ss[RIF];
#pragma unroll
        for (int t = 0; t < RIF; ++t) { const int m = m0 + t * NGW; const bf16_t* xr = src + (size_t)(m < MT ? m : m0) * DM + 8 * lane;
            r[t][0] = *(const u32x4*)xr; r[t][1] = *(const u32x4*)(xr + 512); }
#pragma unroll
        for (int t = 0; t < RIF; ++t) { float s = 0.f;
#pragma unroll
            for (int j = 0; j < 2; ++j)
#pragma unroll
                for (int e = 0; e < 4; ++e) { const float lo = bf2f(r[t][j][e] & 0xffffu), hi = bf2f(r[t][j][e] >> 16); s += lo * lo + hi * hi; }
            ss[t] = s; }
#pragma unroll
        for (int t = 0; t < RIF; ++t) { const int m = m0 + t * NGW; if (m >= MT) break; const int b = m >> 13;
            const float* sh = mod + b * NMOD + (3 * sub + 0) * DM, *scl = mod + b * NMOD + (3 * sub + 1) * DM;
            const float rstd = 1.f / sqrtf(wave_sum(ss[t]) * (1.f / DM) + 1e-6f);
#pragma unroll
            for (int j = 0; j < 2; ++j) { const f32x4 sa = *(const f32x4*)(scl + 512 * j + 8 * lane), sb = *(const f32x4*)(scl + 512 * j + 8 * lane + 4), ha = *(const f32x4*)(sh + 512 * j + 8 * lane), hb = *(const f32x4*)(sh + 512 * j + 8 * lane + 4);
                const float sv[8] = {sa.x, sa.y, sa.z, sa.w, sb.x, sb.y, sb.z, sb.w}, hv[8] = {ha.x, ha.y, ha.z, ha.w, hb.x, hb.y, hb.z, hb.w};
                float y[8];
#pragma unroll
                for (int e = 0; e < 4; ++e) { const float lo = bf2f(r[t][j][e] & 0xffffu), hi = bf2f(r[t][j][e] >> 16);
                    y[2 * e] = lo * rstd * gf[j][2 * e] * (sv[2 * e] + 1.f) + hv[2 * e]; y[2 * e + 1] = hi * rstd * gf[j][2 * e + 1] * (sv[2 * e + 1] + 1.f) + hv[2 * e + 1]; }
                u32x4 w; w.x = pk2(y[0], y[1]); w.y = pk2(y[2], y[3]); w.z = pk2(y[4], y[5]); w.w = pk2(y[6], y[7]);
                *(u32x4*)(HN + (size_t)m * DM + 512 * j + 8 * lane) = w; } }
    }
}

using pg8::Unit;
struct EpiSwiglu { static constexpr bool PERM = true, AFTER_DRAIN = false; bf16_t* H;
    __device__ __forceinline__ void operator()(const f32x4 (&acc)[2][2][4][2], const Unit& u, int wr, int wc, int fr, int fq) const {
        const int row0 = u.pm * 256 + wr * 64 + fr, col0 = u.pn * 128 + wc * 32 + 8 * fq;
#pragma unroll
        for (int ai = 0; ai < 2; ++ai)
#pragma unroll
            for (int m = 0; m < 4; ++m) { bf16_t* rowp = H + (size_t)(row0 + ai * 128 + m * 16) * FF + col0;
                float h[8];
#pragma unroll
                for (int n = 0; n < 2; ++n)
#pragma unroll
                    for (int e = 0; e < 4; ++e) { const float g = acc[ai][0][m][n][e], uu = acc[ai][1][m][n][e]; h[4 * n + e] = g * sigmoidf_(g) * uu; }
                u32x4 w; w.x = pg8::cvt_pk_bf16(h[0], h[1]); w.y = pg8::cvt_pk_bf16(h[2], h[3]); w.z = pg8::cvt_pk_bf16(h[4], h[5]); w.w = pg8::cvt_pk_bf16(h[6], h[7]);
                *(u32x4*)rowp = w; }
    } };
template <bool BASE_BF, bool OUT_BF> struct EpiResidT { static constexpr bool PERM = true, AFTER_DRAIN = false; const void* base; void* out; const float* gate; float coef;
    __device__ __forceinline__ void operator()(const f32x4 (&acc)[2][2][4][2], const Unit& u, int wr, int wc, int fr, int fq) const {
        const int row0 = u.pm * 256 + wr * 64 + fr, col0 = u.pn * 256 + wc * 32 + 8 * fq, b = (u.pm * 256) >> 13;
        f32x4 gv[2][2];
#pragma unroll
        for (int bj = 0; bj < 2; ++bj)
#pragma unroll
            for (int n = 0; n < 2; ++n) gv[bj][n] = *(const f32x4*)(gate + b * NMOD + col0 + bj * 128 + n * 4) * coef;
#pragma unroll
        for (int ai = 0; ai < 2; ++ai)
#pragma unroll
            for (int m = 0; m < 4; ++m) { const size_t off = (size_t)(row0 + ai * 128 + m * 16) * DM + col0;
#pragma unroll
                for (int bj = 0; bj < 2; ++bj) { f32x4 b0, b1;
                    if (BASE_BF) { const u32x4 r = *(const u32x4*)((const bf16_t*)base + off + bj * 128);
                        b0 = (f32x4){bf2f(r.x & 0xffffu), bf2f(r.x >> 16), bf2f(r.y & 0xffffu), bf2f(r.y >> 16)}; b1 = (f32x4){bf2f(r.z & 0xffffu), bf2f(r.z >> 16), bf2f(r.w & 0xffffu), bf2f(r.w >> 16)}; }
                    else { b0 = *(const f32x4*)((const float*)base + off + bj * 128); b1 = *(const f32x4*)((const float*)base + off + bj * 128 + 4); }
                    const f32x4 o0 = b0 + gv[bj][0] * acc[ai][bj][m][0], o1 = b1 + gv[bj][1] * acc[ai][bj][m][1];
                    if (OUT_BF) { u32x4 w; w.x = pg8::cvt_pk_bf16(o0.x, o0.y); w.y = pg8::cvt_pk_bf16(o0.z, o0.w); w.z = pg8::cvt_pk_bf16(o1.x, o1.y); w.w = pg8::cvt_pk_bf16(o1.z, o1.w);
                        *(u32x4*)((bf16_t*)out + off + bj * 128) = w; }
                    else { *(f32x4*)((float*)out + off + bj * 128) = o0; *(f32x4*)((float*)out + off + bj * 128 + 4) = o1; } } }
    } };
struct EpiZ { static constexpr bool PERM = true, AFTER_DRAIN = false; bf16_t* Z; float* side;
    __device__ __forceinline__ void operator()(const f32x4 (&acc)[2][2][4][2], const Unit& u, int wr, int wc, int fr, int fq) const {
        const int row0 = u.pm * 256 + wr * 64 + fr, col0 = u.pn * 256 + wc * 32 + 8 * fq;
#pragma unroll
        for (int ai = 0; ai < 2; ++ai)
#pragma unroll
            for (int m = 0; m < 4; ++m) { const int row = row0 + ai * 128 + m * 16; bf16_t* rowp = Z + (size_t)row * NZ + col0;
#pragma unroll
                for (int bj = 0; bj < 2; ++bj) { const f32x4 v0 = acc[ai][bj][m][0], v1 = acc[ai][bj][m][1];
                    u32x4 w; w.x = pg8::cvt_pk_bf16(v0[0], v0[1]); w.y = pg8::cvt_pk_bf16(v0[2], v0[3]); w.z = pg8::cvt_pk_bf16(v1[0], v1[1]); w.w = pg8::cvt_pk_bf16(v1[2], v1[3]);
                    *(u32x4*)(rowp + bj * 128) = w; }
                if (u.pn == 9 && wc == 1 && fq < 2) {
                    float* sp = side + (size_t)row * 16 + 8 * fq; *(f32x4*)sp = acc[ai][1][m][0]; *(f32x4*)(sp + 4) = acc[ai][1][m][1]; } }
    } };
template <bool SECOND> struct EpiGate { static constexpr bool PERM = true, AFTER_DRAIN = false; bf16_t* MG; const bf16_t* Zg;
    __device__ __forceinline__ void operator()(const f32x4 (&acc)[2][2][4][2], const Unit& u, int wr, int wc, int fr, int fq) const {
        const int row0 = u.pm * 256 + wr * 64 + fr, col0 = u.pn * 256 + wc * 32 + 8 * fq;
#pragma unroll
        for (int ai = 0; ai < 2; ++ai)
#pragma unroll
            for (int m = 0; m < 4; ++m) { const int row = row0 + ai * 128 + m * 16;
#pragma unroll
                for (int bj = 0; bj < 2; ++bj) { const u32x4 gr = *(const u32x4*)(Zg + (size_t)row * NZ + col0 + bj * 128);
                    bf16_t* mp = MG + (size_t)row * DM + col0 + bj * 128;
                    float o[8];
#pragma unroll
                    for (int e = 0; e < 4; ++e) { const float a = acc[ai][bj][m][e >> 1][2 * (e & 1)], bq = acc[ai][bj][m][e >> 1][2 * (e & 1) + 1];
                        o[2 * e] = a * sigmoidf_(bf2f(gr[e] & 0xffffu)); o[2 * e + 1] = bq * sigmoidf_(bf2f(gr[e] >> 16)); }
                    if (SECOND) { const u32x4 pr = *(const u32x4*)mp;
#pragma unroll
                        for (int e = 0; e < 4; ++e) { o[2 * e] += bf2f(pr[e] & 0xffffu); o[2 * e + 1] += bf2f(pr[e] >> 16); } }
                    u32x4 w; w.x = pg8::cvt_pk_bf16(o[0], o[1]); w.y = pg8::cvt_pk_bf16(o[2], o[3]); w.z = pg8::cvt_pk_bf16(o[4], o[5]); w.w = pg8::cvt_pk_bf16(o[6], o[7]);
                    *(u32x4*)mp = w; } }
    } };

__device__ __forceinline__ void unpack8(const u32x4 r, float (&v)[8]) {
#pragma unroll
    for (int e = 0; e < 4; ++e) { v[2 * e] = bf2f(r[e] & 0xffffu); v[2 * e + 1] = bf2f(r[e] >> 16); } }
__device__ __forceinline__ u32x4 pack8(const float (&v)[8]) { u32x4 w; w.x = pk2(v[0], v[1]); w.y = pk2(v[2], v[3]); w.z = pk2(v[4], v[5]); w.w = pk2(v[6], v[7]); return w; }
__device__ __forceinline__ float grp8_sum(float s) { s += __shfl_xor(s, 1); s += __shfl_xor(s, 2); s += __shfl_xor(s, 4); return s; }
__device__ __forceinline__ void phase_post(const Params& p) {
    const int tid = threadIdx.x, lane = tid & 63, wid = rfl(tid >> 6);
    const int gw = blockIdx.x * 8 + wid, NGW = gridDim.x * 8;
    bf16_t* Z = (bf16_t*)(p.ws + WS_Z);
    const float* side = (const float*)(p.ws + WS_SIDE);
    float* LF = (float*)(p.ws + WS_LF); float* WQ = (float*)(p.ws + WS_WQ);
    const int d8 = 8 * (lane & 7);
    float gfq[8], gfk[8], gdq[8], gdk[8];
#pragma unroll
    for (int e = 0; e < 8; ++e) { gfq[e] = p.fox_g[d8 + e] * C2; gfk[e] = p.fox_g[64 + d8 + e]; gdq[e] = p.dsa_g[d8 + e] * C2; gdk[e] = p.dsa_g[64 + d8 + e]; }
    float myinv = p.invfA[0];
#pragma unroll
    for (int e = 1; e < 8; ++e) if (lane == e) myinv = p.invfA[e];
#pragma unroll
    for (int e = 0; e < 4; ++e) if (lane >= 8 && (lane & 3) == e) myinv = p.invfI[e];
    u32x4 nx_q, nx_k, nx_dq, nx_c4; int nx_pos = 0;
    if (gw < MT) { const bf16_t* z0 = Z + (size_t)gw * NZ; nx_q = *(const u32x4*)(z0 + ZQ + 8 * lane); nx_k = *(const u32x4*)(z0 + ZK + 8 * lane); nx_dq = *(const u32x4*)(z0 + ZDQ + 8 * lane); nx_c4 = *(const u32x4*)(z0 + ZDK + 8 * lane); nx_pos = p.pos[gw]; }
    for (int m = gw; m < MT; m += NGW) {
        bf16_t* zr = Z + (size_t)m * NZ;
        const u32x4 ld_q = nx_q, ld_k = nx_k, ld_dq = nx_dq, ld_c4 = nx_c4;
        const int posm = nx_pos;
        if (m + NGW < MT) { const bf16_t* z1 = Z + (size_t)(m + NGW) * NZ; nx_q = *(const u32x4*)(z1 + ZQ + 8 * lane); nx_k = *(const u32x4*)(z1 + ZK + 8 * lane); nx_dq = *(const u32x4*)(z1 + ZDQ + 8 * lane); nx_c4 = *(const u32x4*)(z1 + ZDK + 8 * lane); nx_pos = p.pos[m + NGW]; }
        const float ang = (float)posm * myinv;
        const double rev = (double)ang * 0.15915494309189535; const float fr = (float)(rev - rint(rev));
        const float cs = __builtin_amdgcn_cosf(fr), sn = __builtin_amdgcn_sinf(fr);
        float cA[8], sA[8], cI[4], sI[4];
#pragma unroll
        for (int e = 0; e < 8; ++e) { cA[e] = __shfl(cs, e); sA[e] = __shfl(sn, e); }
#pragma unroll
        for (int e = 0; e < 4; ++e) { cI[e] = __shfl(cs, 8 + e); sI[e] = __shfl(sn, 8 + e); }
        float v[8];
        { u32x4 r = ld_q; unpack8(r, v); float s = 0.f;
#pragma unroll
          for (int e = 0; e < 8; ++e) s += v[e] * v[e];
          const float rs = 1.f / sqrtf(grp8_sum(s) * (1.f / 64.f) + 1e-6f);
#pragma unroll
          for (int e = 0; e < 8; ++e) v[e] = v[e] * rs * gfq[e];
          *(u32x4*)(zr + ZQ + 8 * lane) = pack8(v); }
        { u32x4 r = ld_k; unpack8(r, v); float s = 0.f;
#pragma unroll
          for (int e = 0; e < 8; ++e) s += v[e] * v[e];
          const float rs = 1.f / sqrtf(grp8_sum(s) * (1.f / 64.f) + 1e-6f);
#pragma unroll
          for (int e = 0; e < 8; ++e) v[e] = v[e] * rs * gfk[e];
          *(u32x4*)(zr + ZK + 8 * lane) = pack8(v); }
        { u32x4 r = ld_dq; unpack8(r, v); float s = 0.f;
#pragma unroll
          for (int e = 0; e < 8; ++e) s += v[e] * v[e];
          const float rs = 1.f / sqrtf(grp8_sum(s) * (1.f / 64.f) + 1e-6f);
          const int li = lane & 7;
#pragma unroll
          for (int e = 0; e < 8; ++e) { const float y = v[e] * rs * p.dsa_g[d8 + e]; const float o = __shfl_xor(y, 1);
              v[e] = (li == 0 ? y * cA[e] - o * sA[e] : li == 1 ? y * cA[e] + o * sA[e] : y) * C2; }
          *(u32x4*)(zr + ZDQ + 8 * lane) = pack8(v); }
        { u32x4 r = ld_c4; unpack8(r, v); float s = 0.f;
#pragma unroll
          for (int e = 0; e < 8; ++e) s += v[e] * v[e];
          const float rs = 1.f / sqrtf(grp8_sum(s) * (1.f / 64.f) + 1e-6f);
          float y[8], o[8];
#pragma unroll
          for (int e = 0; e < 8; ++e) { y[e] = v[e] * rs * gdk[e]; o[e] = __shfl_xor(y[e], 1); }
          if (lane < 8) {
#pragma unroll
              for (int e = 0; e < 8; ++e) v[e] = lane == 0 ? y[e] * cA[e] - o[e] * sA[e] : lane == 1 ? y[e] * cA[e] + o[e] * sA[e] : y[e];
              *(u32x4*)(zr + ZDK + 8 * lane) = pack8(v);
          } else if ((lane >= 16 && lane < 48 && ((lane - 16) & 3) == 0) || lane == 48) {
              float w[8];
#pragma unroll
              for (int e = 0; e < 4; ++e) { w[e] = v[e] * cI[e] - v[e + 4] * sI[e]; w[e + 4] = v[e + 4] * cI[e] + v[e] * sI[e]; }
              *(u32x4*)(zr + ZDK + 8 * lane) = pack8(w);
          } else if (lane >= 8 && lane < 16) { const int e = lane - 8;
              const float xx = side[(size_t)m * 16 + e] + p.fbias[e]; LF[(size_t)m * 8 + e] = fminf(xx, 0.f) - log1pf(__expf(-fabsf(xx)));
          } else if (lane >= 52 && lane < 60) { const int e = lane - 52;
              WQ[(size_t)m * 8 + e] = side[(size_t)m * 16 + 8 + e] * 0.0625f;
          } }
    }
}

__device__ __forceinline__ void phase_cumsum(const Params& p, LAS unsigned char* lds) {
    if (blockIdx.x >= 64) return;
    const int tid = threadIdx.x, lane = tid & 63, wid = rfl(tid >> 6);
    const int b = blockIdx.x >> 3, h = blockIdx.x & 7;
    const float* LF = (const float*)(p.ws + WS_LF); float* F2 = (float*)(p.ws + WS_F2) + (size_t)blockIdx.x * SEQ;
    LAS double* wt = (LAS double*)lds;
    float v[16]; float run = 0.f; const int s0 = 16 * tid;
#pragma unroll
    for (int i = 0; i < 16; ++i) { run += LF[((size_t)b * SEQ + s0 + i) * 8 + h]; v[i] = run; }
    double inc = (double)run;
#pragma unroll
    for (int o = 1; o < 64; o <<= 1) { const double t = __shfl_up(inc, o); if (lane >= o) inc += t; }
    if (lane == 63) wt[wid] = inc;
    __syncthreads();
    double pre = inc - (double)run;
    for (int w = 0; w < wid; ++w) pre += wt[w];
#pragma unroll
    for (int i = 0; i < 16; ++i) F2[s0 + i] = (float)((pre + (double)v[i]) * 1.4426950408889634);
    __syncthreads();
}

__device__ __forceinline__ f32x16 mfma32(bf16x8 a, bf16x8 b, f32x16 c) { return __builtin_amdgcn_mfma_f32_32x32x16_bf16(a, b, c, 0, 0, 0); }
__device__ __forceinline__ f32x4 mfma16(bf16x8 a, bf16x8 b, f32x4 c) { return __builtin_amdgcn_mfma_f32_16x16x32_bf16(a, b, c, 0, 0, 0); }
__device__ __forceinline__ s16x4 vtr(LAS const unsigned char* pp) { return __builtin_bit_cast(s16x4, __builtin_amdgcn_ds_read_tr16_b64_v4i16((LAS s16x4*)pp)); }
#ifndef FOX_SKIP
#define FOX_SKIP 1
#endif
__device__ __forceinline__ void fox_tile(LAS const unsigned char* Kb, LAS const unsigned char* Vb, LAS const float* Fb, LAS float* wsf, const bf16x8 (&qr)[4], float Fq, int kt, int kt_my_last, int qw,
                                         int r32, int hi, int trq, int trp, float& m_run, float& l_run, f32x16& o0, f32x16& o1) {
    constexpr int KST = 144;


            f32x16 p0, p1;
#pragma unroll
            for (int g4 = 0; g4 < 4; ++g4) { const f32x4 fa = *(LAS const f32x4*)(Fb + 8 * g4 + 4 * hi), fb = *(LAS const f32x4*)(Fb + 32 + 8 * g4 + 4 * hi);
#pragma unroll
                for (int i = 0; i < 4; ++i) { p0[4 * g4 + i] = fa[i]; p1[4 * g4 + i] = fb[i]; } }
#pragma unroll
            for (int d0 = 0; d0 < 4; ++d0) { const bf16x8 a0 = *(LAS const bf16x8*)(Kb + r32 * KST + (d0 * 16 + hi * 8) * 2), a1 = *(LAS const bf16x8*)(Kb + (32 + r32) * KST + (d0 * 16 + hi * 8) * 2);
                p0 = mfma32(a0, qr[d0], p0); p1 = mfma32(a1, qr[d0], p1); }
            if (kt == kt_my_last) { const int qrel = qw + r32 - kt * 64;
#pragma unroll
                for (int r = 0; r < 16; ++r) { const int kv = crow(r, hi); if (kv > qrel) p0[r] = -INFINITY; if (kv + 32 > qrel) p1[r] = -INFINITY; } }
            float rm = fmaxf(p0[0], p1[0]);
#pragma unroll
            for (int r = 1; r < 16; ++r) rm = fmaxf(rm, fmaxf(p0[r], p1[r]));
            rm = fmaxf(rm, __shfl_xor(rm, 32));
            if (__any(rm > m_run)) {
                const float mn = fmaxf(m_run, rm); const float alpha = ex2(m_run - mn); m_run = mn; l_run *= alpha;
                if (hi == 0) wsf[r32] = alpha;
#pragma unroll
                for (int g4 = 0; g4 < 4; ++g4) { const f32x4 al = *(LAS const f32x4*)(wsf + 8 * g4 + 4 * hi);
#pragma unroll
                    for (int i = 0; i < 4; ++i) { o0[4 * g4 + i] *= al[i]; o1[4 * g4 + i] *= al[i]; } } }
            float sum = 0.f;
#pragma unroll
            for (int r = 0; r < 16; ++r) { p0[r] = ex2(p0[r] - m_run); p1[r] = ex2(p1[r] - m_run); sum += p0[r] + p1[r]; }
            sum += __shfl_xor(sum, 32); l_run += sum;
            bf16x8 pa[4];
#pragma unroll
            for (int s = 0; s < 2; ++s) { u32x4 w0, w1;
#pragma unroll
                for (int e = 0; e < 4; ++e) { w0[e] = pg8::cvt_pk_bf16(p0[8 * s + 2 * e], p0[8 * s + 2 * e + 1]); w1[e] = pg8::cvt_pk_bf16(p1[8 * s + 2 * e], p1[8 * s + 2 * e + 1]); }
                pa[s] = __builtin_bit_cast(bf16x8, w0); pa[2 + s] = __builtin_bit_cast(bf16x8, w1); }
#pragma unroll
            for (int ks = 0; ks < 4; ++ks) {
#pragma unroll
                for (int d0 = 0; d0 < 2; ++d0) { LAS const unsigned char* vp = Vb + (16 * ks + 4 * hi + trq) * KST + (32 * d0 + 16 * (r32 >> 4) + 4 * trp) * 2;
                    const s16x4 lo = vtr(vp), hh = vtr(vp + 8 * KST);
                    const bf16x8 vf = (bf16x8){lo[0], lo[1], lo[2], lo[3], hh[0], hh[1], hh[2], hh[3]};
                    if (d0 == 0) o0 = mfma32(pa[ks], vf, o0); else o1 = mfma32(pa[ks], vf, o1); } }

}
__device__ __forceinline__ void fox_unit(const Params& p, LAS unsigned char* lds, int b, int h, int qb, float thr2) {
    const int tid = threadIdx.x, lane = tid & 63, r32 = lane & 31, hi = lane >> 5, wid = rfl(tid >> 6);
    const bf16_t* Z = (const bf16_t*)(p.ws + WS_Z);
    bf16_t* Y = (bf16_t*)(p.ws + WS_Y);
    const float* F2 = (const float*)(p.ws + WS_F2) + (size_t)(b * 8 + h) * SEQ;
    const int q0 = qb * 256, qw = q0 + wid * 32;
    const size_t rowb = (size_t)b * SEQ;
    constexpr int KST = 144, KBYTES = 64 * KST;
    LAS unsigned char* Kl = lds; LAS unsigned char* Vl = lds + 4 * KBYTES; LAS float* Fl = (LAS float*)(lds + 8 * KBYTES); LAS float* wsf = (LAS float*)(lds + 8 * KBYTES + 1024) + wid * 64;
    const int NT = 4 * qb + 4;
    const int kt_my_last = qw >> 6, st_last = NT / 2 - 1;
    const int srow = tid >> 3, sch = tid & 7;
    const bf16_t* kg = Z + (rowb + srow) * NZ + ZK + h * 64 + sch * 8; const bf16_t* vg = Z + (rowb + srow) * NZ + ZV + h * 64 + sch * 8;
    u32x4 kra, krb, vra, vrb; float freg = 0.f;
#define FX_LOAD(st) do { kra = *(const u32x4*)(kg + (size_t)(st) * 128 * NZ); krb = *(const u32x4*)(kg + ((size_t)(st) * 128 + 64) * NZ); \
        vra = *(const u32x4*)(vg + (size_t)(st) * 128 * NZ); vrb = *(const u32x4*)(vg + ((size_t)(st) * 128 + 64) * NZ); if (tid < 128) freg = F2[(st) * 128 + tid]; } while (0)
#define FX_STORE(bf) do { *(LAS u32x4*)(Kl + (2 * (bf)) * KBYTES + srow * KST + sch * 16) = kra; *(LAS u32x4*)(Kl + (2 * (bf) + 1) * KBYTES + srow * KST + sch * 16) = krb; \
        *(LAS u32x4*)(Vl + (2 * (bf)) * KBYTES + srow * KST + sch * 16) = vra; *(LAS u32x4*)(Vl + (2 * (bf) + 1) * KBYTES + srow * KST + sch * 16) = vrb; if (tid < 128) Fl[(bf) * 128 + tid] = Fref - freg; } while (0)
    FX_LOAD(st_last);
    bf16x8 qr[4];
    { const bf16_t* qp = Z + (rowb + qw + r32) * NZ + ZQ + h * 64 + hi * 8;
#pragma unroll
      for (int d0 = 0; d0 < 4; ++d0) qr[d0] = *(const bf16x8*)(qp + d0 * 16); }
    const float Fq = 0.f, Fref = F2[q0];
    int kt0 = 0, ktw = 0;
#if FOX_SKIP
    { const float Fw = F2[qw]; const int ta = lane, tb = lane + 64;
      const float fu = tid < NT - 4 ? F2[64 * tid + 63] : 0.f, fa = ta < NT - 4 ? F2[64 * ta + 63] : 0.f, fb = tb < NT - 4 ? F2[64 * tb + 63] : 0.f;
      kt0 = __syncthreads_count((tid < NT - 4 && (fu - Fref) > thr2) ? 1 : 0);
      const bool pa = ta < NT - 4 && (fa - Fw) > thr2, pb = tb < NT - 4 && (fb - Fw) > thr2;
      ktw = __popcll(__ballot(pa)) + __popcll(__ballot(pb)); }
#endif
    float m_run = -INFINITY, l_run = 0.f; f32x16 o0, o1;
#pragma unroll
    for (int r = 0; r < 16; ++r) { o0[r] = 0.f; o1[r] = 0.f; }
    const int st0 = kt0 >> 1;
    FX_STORE(0); __syncthreads();
    const int trq = (lane & 15) >> 2, trp = lane & 3;
    for (int st = st_last; st >= st0; --st) {
        const int buf = (st_last - st) & 1;
        if (st > st0) FX_LOAD(st - 1);
        if (2 * st + 1 >= ktw && 2 * st + 1 <= kt_my_last) fox_tile(Kl + (2 * buf + 1) * KBYTES, Vl + (2 * buf + 1) * KBYTES, Fl + buf * 128 + 64, wsf, qr, Fq, 2 * st + 1, kt_my_last, qw, r32, hi, trq, trp, m_run, l_run, o0, o1);
        if (2 * st >= ktw && 2 * st <= kt_my_last) fox_tile(Kl + (2 * buf) * KBYTES, Vl + (2 * buf) * KBYTES, Fl + buf * 128, wsf, qr, Fq, 2 * st, kt_my_last, qw, r32, hi, trq, trp, m_run, l_run, o0, o1);
        if (st > st0) FX_STORE(buf ^ 1);
        __syncthreads();
    }
#undef FX_LOAD
#undef FX_STORE
    if (hi == 0) wsf[32 + r32] = l_run;
#pragma unroll
    for (int g4 = 0; g4 < 4; ++g4) { const f32x4 lv = *(LAS const f32x4*)(wsf + 32 + 8 * g4 + 4 * hi);
#pragma unroll
        for (int i = 0; i < 4; ++i) { const int r = 4 * g4 + i; const float rl = 1.f / lv[i]; bf16_t* yp = Y + (rowb + qw + crow(r, hi)) * 512 + h * 64 + r32;
            yp[0] = (bf16_t)f2bf(o0[r] * rl); yp[32] = (bf16_t)f2bf(o1[r] * rl); } }
}

__device__ __forceinline__ unsigned sortable(float f) { const unsigned u = __float_as_uint(f); return u ^ ((unsigned)((int)u >> 31) | 0x80000000u); }
constexpr int DS_HIST = 0, DS_CAND = 0, DS_SEL = 65792, DS_PREF = 98560, DS_REM = DS_PREF + 256, DS_CNT = DS_REM + 256, DS_CEQ = DS_CNT + 256, DS_CCNT = DS_CEQ + 256, DS_PREF1 = DS_CCNT + 256, DS_IQ = DS_PREF1 + 256, DS_WQ = DS_IQ + 64 * 528, DS_VST = 0;
constexpr int DS_CAP = 256;
__device__ __forceinline__ int mapA(unsigned key) { const int t = (int)(key >> 20); const int dp = 128 + min(max(t - 2992, 0), 127), dn = min(max(t - 976, 0), 127); return t >= 2048 ? dp : dn; }
__device__ __forceinline__ int bucketf(float f) { const unsigned u = __float_as_uint(f); const int idx = (int)((u >> 20) & 0x7FFu); const int c = min(max(idx - 816, 128), 255); return c ^ (((int)u >> 31) & 255); }
typedef float f32x2v __attribute__((ext_vector_type(2)));
__device__ __forceinline__ float bucket_lo(int b) {
    if (b <= 0) return -INFINITY; if (b >= 256) return INFINITY;
    if (b < 128) return -__uint_as_float((((unsigned)(1072 - b)) << 20) - 1u);
    if (b == 128) return 0.f;
    return __uint_as_float(((unsigned)(b + 816)) << 20);
}
template <int MODE> __device__ __forceinline__ void dsa_sweep(const bf16_t* Zb, int c, int wid, int lane, LAS unsigned char* lds, unsigned pref, unsigned pref2 = 0u) {
    constexpr int SHIFT = 24 - 8 * (MODE & 3);
    const int r32 = lane & 31, hi = lane >> 5, ql = 32 * (wid & 1) + r32;
    LAS unsigned* hist = (LAS unsigned*)(lds + DS_HIST) + ql;   LAS unsigned short* sel = (LAS unsigned short*)(lds + DS_SEL) + ql * 256; LAS unsigned* cnt = (LAS unsigned*)(lds + DS_CNT) + ql;
    LAS unsigned* cand = (LAS unsigned*)(lds + DS_CAND) + ql * DS_CAP; LAS unsigned* ccnt = (LAS unsigned*)(lds + DS_CCNT) + ql;
    LAS const unsigned char* iqb = lds + DS_IQ + ql * 528 + hi * 16; LAS const float* wqb = (LAS const float*)(lds + DS_WQ) + ql;
    const int kt0 = wid >> 1; const int nit = kt0 <= c ? 2 * ((c - kt0) / 4 + 1) : 0;
    const float t_lo = bucket_lo((int)pref), t_hi = bucket_lo((int)pref + 1);
    const bf16_t* ikp = Zb + (size_t)(64 * kt0 + r32) * NZ + ZIK + hi * 8;
    bf16x8 a0, a1;
    if (nit > 0) { a0 = *(const bf16x8*)ikp; a1 = *(const bf16x8*)(ikp + 16); }
#pragma unroll 1
    for (int it = 0; it < nit; ++it) {
        const int kt = kt0 + 4 * (it >> 1), kb = it & 1;
        const int itn = it + 1 < nit ? it + 1 : it;
        const bf16_t* np = ikp + (size_t)(256 * (itn >> 1) + 32 * (itn & 1)) * NZ; const bf16x8 n0 = *(const bf16x8*)np, n1 = *(const bf16x8*)(np + 16);
        f32x2v sc2[8];
#pragma unroll
        for (int r = 0; r < 8; ++r) sc2[r] = (f32x2v){0.f, 0.f};
#define SW_MF(hp, D0, D1, W0, W1) do { const bf16x8 b00 = *(LAS const bf16x8*)(iqb + (2 * (hp)) * 64), b01 = *(LAS const bf16x8*)(iqb + (2 * (hp)) * 64 + 32), \
            b10 = *(LAS const bf16x8*)(iqb + (2 * (hp) + 1) * 64), b11 = *(LAS const bf16x8*)(iqb + (2 * (hp) + 1) * 64 + 32); W0 = wqb[(2 * (hp)) * 64]; W1 = wqb[(2 * (hp) + 1) * 64]; \
            D0 = mfma32(a0, b00, zero16); D1 = mfma32(a0, b10, zero16); D0 = mfma32(a1, b01, D0); D1 = mfma32(a1, b11, D1); } while (0)
#define SW_VA(D0, D1, W0, W1) do { const f32x2v w0_ = (f32x2v){W0, W0}, w1_ = (f32x2v){W1, W1}; \
            _Pragma("unroll") for (int r = 0; r < 8; ++r) { const f32x2v e0 = (f32x2v){fmaxf(D0[2 * r], 0.f), fmaxf(D0[2 * r + 1], 0.f)}, e1 = (f32x2v){fmaxf(D1[2 * r], 0.f), fmaxf(D1[2 * r + 1], 0.f)}; \
                sc2[r] = __builtin_elementwise_fma(e0, w0_, sc2[r]); sc2[r] = __builtin_elementwise_fma(e1, w1_, sc2[r]); } } while (0)
        { f32x16 zero16;
#pragma unroll
          for (int r = 0; r < 16; ++r) zero16[r] = 0.f;
          f32x16 dA0, dA1, dB0, dB1; float wA0, wA1, wB0, wB1;
          SW_MF(0, dA0, dA1, wA0, wA1);
          SW_MF(1, dB0, dB1, wB0, wB1); __builtin_amdgcn_sched_barrier(0);
          SW_VA(dA0, dA1, wA0, wA1);    __builtin_amdgcn_sched_barrier(0);
          SW_MF(2, dA0, dA1, wA0, wA1); __builtin_amdgcn_sched_barrier(0);
          SW_VA(dB0, dB1, wB0, wB1);    __builtin_amdgcn_sched_barrier(0);
          SW_MF(3, dB0, dB1, wB0, wB1); __builtin_amdgcn_sched_barrier(0);
          SW_VA(dA0, dA1, wA0, wA1);    __builtin_amdgcn_sched_barrier(0);
          SW_VA(dB0, dB1, wB0, wB1); }
#undef SW_MF
#undef SW_VA
        f32x16 sc;
#pragma unroll
        for (int r = 0; r < 16; ++r) sc[r] = sc2[r >> 1][r & 1];
        const unsigned s0 = (unsigned)(64 * kt + 32 * kb + 4 * hi);
#pragma unroll
        for (int r = 0; r < 16; ++r) { const unsigned s = s0 + (unsigned)((r & 3) + 8 * (r >> 2));
            if (MODE == 5) { __hip_atomic_fetch_add(hist + 64 * bucketf(sc[r]), 1u, __ATOMIC_RELAXED, __HIP_MEMORY_SCOPE_WORKGROUP); continue; }
            if (MODE == 6) {
                if (sc[r] >= t_hi) { const unsigned pos = __hip_atomic_fetch_add(cnt, 1u, __ATOMIC_RELAXED, __HIP_MEMORY_SCOPE_WORKGROUP); sel[pos & 255u] = (unsigned short)s; }
                else if (sc[r] >= t_lo) { const unsigned key = (sortable(sc[r]) & 0xFFFFE000u) | (8191u - s);
                    const unsigned pos = __hip_atomic_fetch_add(ccnt, 1u, __ATOMIC_RELAXED, __HIP_MEMORY_SCOPE_WORKGROUP); cand[pos & (DS_CAP - 1)] = key; }
                continue; }
            if (MODE == 7) { if (bucketf(sc[r]) == (int)pref) { const unsigned key = (sortable(sc[r]) & 0xFFFFE000u) | (8191u - s);
                    __hip_atomic_fetch_add(hist + 64 * ((key >> 12) & 255u), 1u, __ATOMIC_RELAXED, __HIP_MEMORY_SCOPE_WORKGROUP); } continue; }
            if (MODE == 8) { const int dA = bucketf(sc[r]);
                if (dA > (int)pref) { const unsigned pos = __hip_atomic_fetch_add(cnt, 1u, __ATOMIC_RELAXED, __HIP_MEMORY_SCOPE_WORKGROUP); sel[pos & 255u] = (unsigned short)s; }
                else if (dA == (int)pref) { const unsigned key = (sortable(sc[r]) & 0xFFFFE000u) | (8191u - s); const unsigned sub = (key >> 12) & 255u;
                    if (sub > pref2) { const unsigned pos = __hip_atomic_fetch_add(cnt, 1u, __ATOMIC_RELAXED, __HIP_MEMORY_SCOPE_WORKGROUP); sel[pos & 255u] = (unsigned short)s; }
                    else if (sub == pref2) { const unsigned pos = __hip_atomic_fetch_add(ccnt, 1u, __ATOMIC_RELAXED, __HIP_MEMORY_SCOPE_WORKGROUP); cand[pos & (DS_CAP - 1)] = key; } }
                continue; }
            const unsigned key = (sortable(sc[r]) & 0xFFFFE000u) | (8191u - s);
            if (MODE < 4) { bool ok = true; if (SHIFT < 24) ok = (key >> ((SHIFT + 8) & 31)) == pref;
                if (ok) __hip_atomic_fetch_add(hist + 64 * ((key >> (SHIFT & 31)) & 255u), 1u, __ATOMIC_RELAXED, __HIP_MEMORY_SCOPE_WORKGROUP); }
            else if (MODE == 4) { if (key >= pref) { const unsigned pos = __hip_atomic_fetch_add(cnt, 1u, __ATOMIC_RELAXED, __HIP_MEMORY_SCOPE_WORKGROUP); sel[pos & 255u] = (unsigned short)s; } }
            else if (MODE == 5) { __hip_atomic_fetch_add(hist + 64 * mapA(key), 1u, __ATOMIC_RELAXED, __HIP_MEMORY_SCOPE_WORKGROUP); }
            else { const int dA = mapA(key);
                if (dA > (int)pref) { const unsigned pos = __hip_atomic_fetch_add(cnt, 1u, __ATOMIC_RELAXED, __HIP_MEMORY_SCOPE_WORKGROUP); sel[pos & 255u] = (unsigned short)s; }
                else if (dA == (int)pref) { const unsigned pos = __hip_atomic_fetch_add(ccnt, 1u, __ATOMIC_RELAXED, __HIP_MEMORY_SCOPE_WORKGROUP); cand[pos & (DS_CAP - 1)] = key; } } }
        a0 = n0; a1 = n1;
    }
}
template <bool FIRST> __device__ __forceinline__ void dsa_digit(LAS unsigned char* lds, int wid, int lane) {
    LAS unsigned* prefv = (LAS unsigned*)(lds + DS_PREF); LAS unsigned* remv = (LAS unsigned*)(lds + DS_REM); LAS unsigned* ceqv = (LAS unsigned*)(lds + DS_CEQ);
    for (int i = 0; i < 8; ++i) { const int ql = 8 * wid + i;
        LAS const unsigned* hp = (LAS const unsigned*)(lds + DS_HIST) + ql + 256 * lane;
        const unsigned rem = remv[ql], c0 = hp[0], c1 = hp[64], c2 = hp[128], c3 = hp[192], s = c0 + c1 + c2 + c3;
        unsigned suf = s;
#pragma unroll
        for (int o = 1; o < 64; o <<= 1) { const unsigned t = __shfl_down(suf, o); if (lane + o < 64) suf += t; }
        unsigned above = suf - s; int found = -1; unsigned nrem = 0, ceq = 0;
        if (above < rem && rem <= above + c3) { found = 3; nrem = rem - above; ceq = c3; } above += c3;
        if (above < rem && rem <= above + c2) { found = 2; nrem = rem - above; ceq = c2; } above += c2;
        if (above < rem && rem <= above + c1) { found = 1; nrem = rem - above; ceq = c1; } above += c1;
        if (above < rem && rem <= above + c0) { found = 0; nrem = rem - above; ceq = c0; }
        if (found >= 0) { prefv[ql] = FIRST ? (unsigned)(4 * lane + found) : ((prefv[ql] << 8) | (unsigned)(4 * lane + found)); remv[ql] = nrem; ceqv[ql] = ceq; } }
}
__device__ __forceinline__ void dsa_unit(const Params& p, LAS unsigned char* lds, int b, int c) {
    const int tid = threadIdx.x, lane = tid & 63, wid = rfl(tid >> 6);
    const bf16_t* Z = (const bf16_t*)(p.ws + WS_Z); bf16_t* Y = (bf16_t*)(p.ws + WS_Y);
    const size_t rowb = (size_t)b * SEQ; const bf16_t* Zb = Z + rowb * NZ;
    const int N = 64 * (c + 1), nsel = N < 256 ? N : 256, t0 = 64 * c;
    LAS unsigned short* selall = (LAS unsigned short*)(lds + DS_SEL);
    LAS unsigned* prefv = (LAS unsigned*)(lds + DS_PREF); LAS unsigned* remv = (LAS unsigned*)(lds + DS_REM); LAS unsigned* cntv = (LAS unsigned*)(lds + DS_CNT);
    LAS unsigned* ceqv = (LAS unsigned*)(lds + DS_CEQ); LAS unsigned* ccntv = (LAS unsigned*)(lds + DS_CCNT);
    if (c <= 3) { for (int i = tid; i < 64 * 256; i += 512) selall[i] = (unsigned short)(((i & 255) < N) ? (i & 255) : 0); }
    else {
        const int r32 = lane & 31, ql = 32 * (wid & 1) + r32;
        {
          const int qq = tid >> 3, ch = tid & 7;
#pragma unroll
          for (int i = 0; i < 4; ++i) { const int pc = ch + 8 * i; const u32x4 v = *(const u32x4*)(Zb + (size_t)(t0 + qq) * NZ + ZIQ + pc * 8); *(LAS u32x4*)(lds + DS_IQ + qq * 528 + pc * 16) = v; }
          ((LAS float*)(lds + DS_WQ))[ch * 64 + qq] = ((const float*)(p.ws + WS_WQ))[(rowb + t0 + qq) * 8 + ch]; }
        if (tid < 64) { prefv[tid] = 0u; remv[tid] = 256u; cntv[tid] = 0u; ccntv[tid] = 0u; }
#define DS_ZERO() do { for (int i = tid; i < 64 * 256; i += 512) ((LAS unsigned*)(lds + DS_HIST))[i] = 0u; __syncthreads(); } while (0)
        DS_ZERO();
        dsa_sweep<5>(Zb, c, wid, lane, lds, 0u); __syncthreads(); dsa_digit<true>(lds, wid, lane); __syncthreads();
        const int bad = (tid < 64) ? (ceqv[tid] > (unsigned)DS_CAP) : 0;
        int path = 0;
        if (!__syncthreads_or(bad)) { dsa_sweep<6>(Zb, c, wid, lane, lds, prefv[ql]); }
        else {
            LAS unsigned* pref1v = (LAS unsigned*)(lds + DS_PREF1);
            const unsigned dst = (tid < 64) ? prefv[tid] : 1u;
            const int sat = __syncthreads_or((dst == 0u || dst == 127u || dst == 128u || dst == 255u) ? 1 : 0);
            int bad2 = 1;
            if (!sat) {
                if (tid < 64) pref1v[tid] = dst;
                DS_ZERO();
                dsa_sweep<7>(Zb, c, wid, lane, lds, pref1v[ql]); __syncthreads(); dsa_digit<true>(lds, wid, lane); __syncthreads();
                bad2 = (tid < 64) ? (ceqv[tid] > (unsigned)DS_CAP) : 0;
                bad2 = __syncthreads_or(bad2);
            }
            if (!bad2) { dsa_sweep<8>(Zb, c, wid, lane, lds, pref1v[ql], prefv[ql]); }
            else {
                path = 2;
            if (tid < 64) { prefv[tid] = 0u; remv[tid] = 256u; }
#define DS_PASS(MD) do { DS_ZERO(); dsa_sweep<MD>(Zb, c, wid, lane, lds, prefv[ql]); __syncthreads(); dsa_digit<false>(lds, wid, lane); __syncthreads(); } while (0)
                DS_PASS(0); DS_PASS(1); DS_PASS(2); DS_PASS(3);
#undef DS_PASS
                dsa_sweep<4>(Zb, c, wid, lane, lds, prefv[ql]);

            }
        }
        __syncthreads();
        if (path != 2) {
            for (int i = 0; i < 8; ++i) { const int q2 = 8 * wid + i; const int n = (int)ceqv[q2], r = (int)remv[q2];
                LAS const unsigned* cd = (LAS const unsigned*)(lds + DS_CAND) + q2 * DS_CAP;
                unsigned kk[4]; int rank[4];
#pragma unroll
                for (int t = 0; t < 4; ++t) { kk[t] = (lane + 64 * t < n) ? cd[lane + 64 * t] : 0xFFFFFFFFu; rank[t] = 0; }
                for (int j = 0; j < n; j += 4) { u32x4 v = *(LAS const u32x4*)(cd + j);
#pragma unroll
                    for (int e = 0; e < 4; ++e) { const unsigned ve = (j + e < n) ? v[e] : 0u;
#pragma unroll
                        for (int t = 0; t < 4; ++t) rank[t] += (ve > kk[t]) ? 1 : 0; } }
#pragma unroll
                for (int t = 0; t < 4; ++t) if (lane + 64 * t < n && rank[t] < r) selall[q2 * 256 + (256 - r) + rank[t]] = (unsigned short)(8191u - (kk[t] & 0x1FFFu)); }
        }
#undef DS_ZERO
    }
    __syncthreads();
    const int n = lane & 15, g = lane >> 4, trq = (lane & 15) >> 2, trp = lane & 3;
    LAS unsigned char* vst = lds + DS_VST + wid * 8192;
#define G_KLOAD(dst, SELP, kb0, cnt) do { _Pragma("unroll") for (int i_ = 0; i_ < (cnt); ++i_) { const int s_ = (SELP)[16 * ((kb0) + i_) + n]; const bf16_t* kp_ = Zb + (size_t)s_ * NZ + ZDK + g * 8; \
        dst[2 * i_] = *(const bf16x8*)kp_; dst[2 * i_ + 1] = *(const bf16x8*)(kp_ + 32); } asm volatile("" ::: "memory"); } while (0)
#define G_S(src, kb0, cnt) do { _Pragma("unroll") for (int i_ = 0; i_ < (cnt); ++i_) { f32x4 acc_ = {0.f, 0.f, 0.f, 0.f}; acc_ = mfma16(src[2 * i_], qf0, acc_); acc_ = mfma16(src[2 * i_ + 1], qf1, acc_); sc[(kb0) + i_] = acc_; } } while (0)
#define G_VLOAD(dst, ch) do { _Pragma("unroll") for (int i_ = 0; i_ < 8; ++i_) { const int pc_ = lane + 64 * i_, rowi_ = pc_ >> 3, c16_ = pc_ & 7; const int s_ = sel[64 * (ch) + rowi_]; \
        dst[i_] = *(const u32x4*)(Zb + (size_t)s_ * NZ + ZDV + c16_ * 8); } asm volatile("" ::: "memory"); } while (0)
#define G_VSTORE(src) do { _Pragma("unroll") for (int i_ = 0; i_ < 8; ++i_) { const int pc_ = lane + 64 * i_, rowi_ = pc_ >> 3, c16_ = pc_ & 7; *(LAS u32x4*)(vst + rowi_ * 128 + c16_ * 16) = src[i_]; } \
        asm volatile("s_waitcnt lgkmcnt(0)" ::: "memory"); } while (0)
#define G_PV(ch) do { _Pragma("unroll") for (int k2 = 0; k2 < 2; ++k2) { const bf16x8 pa_ = pa[2 * (ch) + k2]; \
        _Pragma("unroll") for (int db = 0; db < 4; ++db) { LAS const unsigned char* vp = vst + (32 * k2 + 4 * g + trq) * 128 + (16 * db + 4 * trp) * 2; \
            const s16x4 lo = vtr(vp), hh = vtr(vp + 16 * 128); const bf16x8 vf = (bf16x8){lo[0], lo[1], lo[2], lo[3], hh[0], hh[1], hh[2], hh[3]}; o[db] = mfma16(pa_, vf, o[db]); } } \
        asm volatile("s_waitcnt lgkmcnt(0)" ::: "memory"); } while (0)
    bf16x8 kA[8], qfn0, qfn1;
    { LAS const unsigned short* sel0 = selall + wid * 256; G_KLOAD(kA, sel0, 0, 4);
      const bf16_t* qp = Z + (rowb + t0 + wid) * NZ + ZDQ + (n & 7) * 64 + g * 8; qfn0 = *(const bf16x8*)qp; qfn1 = *(const bf16x8*)(qp + 32); }
#pragma unroll 1
    for (int qi = 0; qi < 8; ++qi) {
        const int ql = wid + 8 * qi; const size_t row = rowb + t0 + ql;
        LAS const unsigned short* sel = selall + ql * 256;
        const bf16x8 qf0 = qfn0, qf1 = qfn1;
        bf16x8 kB[8], kC[8], kD[8]; f32x4 sc[16];
        G_KLOAD(kB, sel, 4, 4);
        G_S(kA, 0, 4);
        G_KLOAD(kC, sel, 8, 4);
        G_S(kB, 4, 4);
        G_KLOAD(kD, sel, 12, 4);
        G_S(kC, 8, 4);
        G_S(kD, 12, 4);
        u32x4 vrA[8], vrB[8];
        G_VLOAD(vrA, 0); G_VLOAD(vrB, 1);
        float mx = -INFINITY; int nlim = nsel - 4 * g; asm volatile("" : "+v"(nlim));
#pragma unroll
        for (int kb = 0; kb < 16; ++kb)
#pragma unroll
            for (int i = 0; i < 4; ++i) { if (16 * kb + i >= nlim) sc[kb][i] = -INFINITY; mx = fmaxf(mx, sc[kb][i]); }
        mx = fmaxf(mx, __shfl_xor(mx, 16)); mx = fmaxf(mx, __shfl_xor(mx, 32));
        float sum = 0.f;
#pragma unroll
        for (int kb = 0; kb < 16; ++kb)
#pragma unroll
            for (int i = 0; i < 4; ++i) { sc[kb][i] = ex2(sc[kb][i] - mx); sum += sc[kb][i]; }
        sum += __shfl_xor(sum, 16); sum += __shfl_xor(sum, 32);
        bf16x8 pa[8];
#pragma unroll
        for (int ks2 = 0; ks2 < 8; ++ks2) { u32x4 w; w.x = pg8::cvt_pk_bf16(sc[2 * ks2][0], sc[2 * ks2][1]); w.y = pg8::cvt_pk_bf16(sc[2 * ks2][2], sc[2 * ks2][3]);
            w.z = pg8::cvt_pk_bf16(sc[2 * ks2 + 1][0], sc[2 * ks2 + 1][1]); w.w = pg8::cvt_pk_bf16(sc[2 * ks2 + 1][2], sc[2 * ks2 + 1][3]); pa[ks2] = __builtin_bit_cast(bf16x8, w); }
        {
          const int qn = qi < 7 ? ql + 8 : ql; LAS const unsigned short* seln = selall + qn * 256; G_KLOAD(kA, seln, 0, 4);
          const bf16_t* qp = Z + (rowb + t0 + qn) * NZ + ZDQ + (n & 7) * 64 + g * 8; qfn0 = *(const bf16x8*)qp; qfn1 = *(const bf16x8*)(qp + 32); }
        f32x4 o[4];
#pragma unroll
        for (int db = 0; db < 4; ++db) o[db] = (f32x4){0.f, 0.f, 0.f, 0.f};
        G_VSTORE(vrA); G_VLOAD(vrA, 2); G_PV(0);
        G_VSTORE(vrB); G_VLOAD(vrB, 3); G_PV(1);
        G_VSTORE(vrA); G_PV(2);
        G_VSTORE(vrB); G_PV(3);
        float rl[4];
#pragma unroll
        for (int i = 0; i < 4; ++i) rl[i] = 1.f / __shfl(sum, (4 * g + i) & 15);
        if (g < 2) {
#pragma unroll
            for (int i = 0; i < 4; ++i)
#pragma unroll
                for (int db = 0; db < 4; ++db) Y[(size_t)MT * 512 + row * 512 + (4 * g + i) * 64 + 16 * db + n] = (bf16_t)f2bf(o[db][i] * rl[i]); }
    }
#undef G_KLOAD
#undef G_S
#undef G_VLOAD
#undef G_VSTORE
#undef G_PV
    __syncthreads();
}
__device__ __forceinline__ void phase_mixer(const Params& p, LAS unsigned char* lds) {
    const int tid = threadIdx.x, lane = tid & 63;
    const int x = blockIdx.x & 7;
    volatile LAS int* slot = (volatile LAS int*)(lds + LDS_BYTES - 128);
    {
        unsigned* q = (unsigned*)p.ws + 4096 + 64 * x;
        int nxt = 0;
        if (tid == 0) nxt = (int)__hip_atomic_fetch_add(q, 1u, __ATOMIC_RELAXED, __HIP_MEMORY_SCOPE_AGENT);
#pragma unroll 1
        for (;;) {
            if (tid == 0) slot[0] = nxt;
            __syncthreads();
            const int u = rfl(slot[0]);
            if (u >= 128) break;
            if (tid == 0) nxt = (int)__hip_atomic_fetch_add(q, 1u, __ATOMIC_RELAXED, __HIP_MEMORY_SCOPE_AGENT);
            dsa_unit(p, lds, x, 127 - u);
        }
    }
    __syncthreads();
    {
        const float mq = wave_max(fabsf(p.fox_g[lane])), mk = wave_max(fabsf(p.fox_g[64 + lane]));
        const float B2 = 8.f * mq * mk * 1.03f * LOG2E; const float thr2 = 2.f * B2 + 112.f * LOG2E;
        unsigned* q = (unsigned*)p.ws + 4096 + 64 * x + 32;
        int nxt = 0;
        if (tid == 0) nxt = (int)__hip_atomic_fetch_add(q, 1u, __ATOMIC_RELAXED, __HIP_MEMORY_SCOPE_AGENT);
#pragma unroll 1
        for (;;) {
            if (tid == 0) slot[1] = nxt;
            __syncthreads();
            const int v = rfl(slot[1]);
            if (v >= 256) break;
            if (tid == 0) nxt = (int)__hip_atomic_fetch_add(q, 1u, __ATOMIC_RELAXED, __HIP_MEMORY_SCOPE_AGENT);
            fox_unit(p, lds, v & 7, x, 31 - (v >> 3), thr2);
            __syncthreads();
        }
    }
}
#define XB_TMO      128
#define XB_XCNT(j)  (256  + 64 * (j))
#define XB_XSUB(j)  (1280 + 64 * (j))
#define XB_XGEN(j)  (2304 + 64 * (j))
#define XB_TOP      3328
#define XB_TOPGEN   3392
#define XCD_BAR_WORDS 3456
#define XB_SPIN_CAP (1u << 18)

__device__ __forceinline__ unsigned xb_ld(unsigned* p)              { return __hip_atomic_load(p, __ATOMIC_RELAXED, __HIP_MEMORY_SCOPE_AGENT); }
__device__ __forceinline__ unsigned xb_add(unsigned* p, unsigned v) { return __hip_atomic_fetch_add(p, v, __ATOMIC_RELAXED, __HIP_MEMORY_SCOPE_AGENT); }
__device__ __forceinline__ unsigned xb_xcc_id() { return (unsigned)__builtin_amdgcn_s_getreg((3 << 11) | 20) & 0xFu; }
#define XB_SPIN(cond, bar) do { unsigned _sp = 0; while (cond) { __builtin_amdgcn_s_sleep(1); \
    if ((++_sp & 255u) == 0u) { if (xb_ld(&(bar)[XB_TMO])) break; if (_sp > XB_SPIN_CAP) { atomicAdd(&(bar)[XB_TMO], 1u); break; } } } } while (0)

struct XcdBarrier {
    unsigned* bar; unsigned x;
    volatile LAS unsigned* st;
};

__device__ __forceinline__ XcdBarrier xcd_barrier_post(unsigned* bar, volatile LAS unsigned* st) {
    XcdBarrier b; b.bar = bar; b.x = xb_xcc_id(); b.st = st;
    if (threadIdx.x == 0) (void)xb_add(&bar[XB_XCNT(b.x)], 1u);
    return b;
}
__device__ __forceinline__ void xcd_barrier_complete(unsigned* bar, unsigned x, unsigned& nloc, unsigned& nx) {
    const unsigned G = gridDim.x * gridDim.y * gridDim.z;
    unsigned sum, cnt, mine, sp = 0u;
    for (;;) {
        sum = 0u; cnt = 0u; mine = 0u;
#pragma unroll
        for (unsigned j = 0; j < 16; ++j) { const unsigned c = xb_ld(&bar[XB_XCNT(j)]); sum += c; cnt += (c > 0u) ? 1u : 0u; mine = (j == x) ? c : mine; }
        if (sum == G) break;
        __builtin_amdgcn_s_sleep(1);
        if ((++sp & 255u) == 0u) { if (xb_ld(&bar[XB_TMO])) break; if (sp > XB_SPIN_CAP) { atomicAdd(&bar[XB_TMO], 1u); break; } }
    }
    nloc = mine > 0u ? mine : 1u; nx = cnt > 0u ? cnt : 1u;
}

__device__ __forceinline__ void xcd_barrier(const XcdBarrier& b) {
    asm volatile("s_waitcnt vmcnt(0)" ::: "memory");
    __syncthreads();
    if (threadIdx.x == 0) {
        unsigned* bar = b.bar;
        __builtin_amdgcn_s_waitcnt(0);
        unsigned nloc = b.st[0], nx = b.st[1];
        if (nloc == 0u) { xcd_barrier_complete(bar, b.x, nloc, nx); b.st[0] = nloc; b.st[1] = nx; }
        const unsigned old = xb_add(&bar[XB_XSUB(b.x)], 1u);
        const unsigned gen = old / nloc;
        if (old + 1u == (gen + 1u) * nloc) {
            __builtin_amdgcn_fence(__ATOMIC_RELEASE, "agent");
            asm volatile("s_waitcnt vmcnt(0)" ::: "memory");
            const unsigned og = xb_add(&bar[XB_TOP], 1u);
            const unsigned tg = og / nx;
            if (og + 1u == (tg + 1u) * nx) xb_add(&bar[XB_TOPGEN], 1u);
            else XB_SPIN(xb_ld(&bar[XB_TOPGEN]) == tg, bar);
            __builtin_amdgcn_fence(__ATOMIC_ACQUIRE, "agent");
            xb_add(&bar[XB_XGEN(b.x)], 1u);
            asm volatile("s_waitcnt vmcnt(0)" ::: "memory");
        } else {
            XB_SPIN(xb_ld(&bar[XB_XGEN(b.x)]) == gen, bar);
            __builtin_amdgcn_fence(__ATOMIC_ACQUIRE, "agent");
            asm volatile("s_waitcnt vmcnt(0)" ::: "memory");
        }
    }
    __syncthreads();
}

__global__ void __launch_bounds__(512, 2) mega(Params p) {
    extern __shared__ __attribute__((aligned(16))) unsigned char lds_raw[];
    LAS unsigned char* lds = (LAS unsigned char*)lds_raw;
    cg::grid_group grid = cg::this_grid();
    const int G = gridDim.x, bx = blockIdx.x;
    unsigned char* ws = p.ws;
    bf16_t* HN = (bf16_t*)(ws + WS_HN); bf16_t* Hh = (bf16_t*)(ws + WS_Z); bf16_t* Zz = (bf16_t*)(ws + WS_Z); bf16_t* Yy = (bf16_t*)(ws + WS_Y);
    const float* mod = (const float*)(ws + WS_MOD);
    bf16_t* X1 = (bf16_t*)p.out;
    bf16_t* X2 = (bf16_t*)(ws + WS_Y);
    unsigned* barw = (unsigned*)ws;
    volatile LAS unsigned* bst = (volatile LAS unsigned*)(lds + LDS_BYTES - 64);
    if (threadIdx.x < 2) bst[threadIdx.x] = 0u;
    if (bx == 0) for (int i = threadIdx.x; i < 4096 + 512; i += 512) __hip_atomic_store(barw + i, 0u, __ATOMIC_RELAXED, __HIP_MEMORY_SCOPE_AGENT);
    __syncthreads();
    XcdBarrier xbar; xbar.bar = barw; xbar.x = 0; xbar.st = bst;
#ifndef PMASK
#define PMASK 0xFFFF
#endif
#define PH(k) (((PMASK >> (k)) & 1) && p.ph_lo <= (k) && (k) < p.ph_hi)
#define SYNC() xcd_barrier(xbar)
#ifndef DUP_MASK
#define DUP_MASK 0
#endif
#define DUP(k)
    DUP(0) if (PH(0)) phase_prologue(p, lds);
    grid.sync();
    xbar = xcd_barrier_post(barw, bst);
    DUP(1) if (PH(1)) phase_norm(p, p.x, 0);
    SYNC();
    DUP(2) if (PH(2)) { pg8::Gemm g{HN, (const bf16_t*)(ws + WS_WUP1), MT, NUP, DM}; pg8::StaticOrder S; S.init(MT, NUP, G, bx); EpiSwiglu E{Hh};
        pg8::gemm_phase<EpiSwiglu, pg8::StaticOrder, true, true>(lds, g, S, E); }
#if (DUP_MASK >> 2) & 1
    __syncthreads(); if (PH(2)) { pg8::Gemm g{HN, (const bf16_t*)(ws + WS_WUP1), MT, NUP, DM}; pg8::StaticOrder S; S.init(MT, NUP, G, bx); EpiSwiglu E{Hh};
        pg8::gemm_phase<EpiSwiglu, pg8::StaticOrder, true, true>(lds, g, S, E); }
#endif
    SYNC();
    if (PH(3)) { pg8::Gemm g{Hh, (const bf16_t*)(ws + WS_WDN1), MT, DM, FF}; pg8::StaticOrder S; S.init(MT, DM, G, bx); EpiResidT<false, true> E{p.x, X1, mod + 2 * DM, 0.5f};
        pg8::gemm_phase<EpiResidT<false, true>, pg8::StaticOrder, true, true>(lds, g, S, E); }
    SYNC();
    if (PH(4)) phase_norm_bf(p, X1, 1);
    SYNC();
    DUP(5) if (PH(5)) { pg8::Gemm g{HN, (const bf16_t*)(ws + WS_WIN), MT, NZ, DM}; pg8::StaticOrder S; S.init(MT, NZ, G, bx); EpiZ E{Zz, (float*)(ws + WS_SIDE)};
        pg8::gemm_phase<EpiZ, pg8::StaticOrder, true, true>(lds, g, S, E); }
    SYNC();
    if (PH(6)) phase_post(p);
    SYNC();
    DUP(7) if (PH(7)) phase_cumsum(p, lds);
    SYNC();
    DUP(8) if (PH(8)) phase_mixer(p, lds);
#if (DUP_MASK >> 8) & 1
    __syncthreads(); if (PH(8)) phase_mixer<1>(p, lds);
#endif
    SYNC();
    if (PH(9)) {
        { pg8::Gemm g{Yy, (const bf16_t*)(ws + WS_WA), MT, DM, 512}; pg8::StaticOrder S; S.init(MT, DM, G, bx); EpiGate<false> E{HN, Zz + ZGA};
          pg8::gemm_phase<EpiGate<false>, pg8::StaticOrder, true, true>(lds, g, S, E); }
        { pg8::Gemm g{Yy + (size_t)MT * 512, (const bf16_t*)(ws + WS_WB), MT, DM, 512}; pg8::StaticOrder S; S.init(MT, DM, G, bx); EpiGate<true> E{HN, Zz + ZGB};
          pg8::gemm_phase<EpiGate<true>, pg8::StaticOrder, true, true>(lds, g, S, E); } }
    SYNC();
    if (PH(10)) { pg8::Gemm g{HN, (const bf16_t*)(ws + WS_WO), MT, DM, DM}; pg8::StaticOrder S; S.init(MT, DM, G, bx); EpiResidT<true, true> E{X1, X2, mod + 5 * DM, 1.0f};
        pg8::gemm_phase<EpiResidT<true, true>, pg8::StaticOrder, true, true>(lds, g, S, E); }
    SYNC();
    if (PH(11)) phase_norm_bf(p, X2, 2);
    SYNC();
    if (PH(12)) { pg8::Gemm g{HN, (const bf16_t*)(ws + WS_WUP2), MT, NUP, DM}; pg8::StaticOrder S; S.init(MT, NUP, G, bx); EpiSwiglu E{Hh};
        pg8::gemm_phase<EpiSwiglu, pg8::StaticOrder, true, true>(lds, g, S, E); }
    SYNC();
    if (PH(13)) { pg8::Gemm g{Hh, (const bf16_t*)(ws + WS_WDN2), MT, DM, FF}; pg8::StaticOrder S; S.init(MT, DM, G, bx); EpiResidT<true, false> E{X2, p.out, mod + 8 * DM, 0.5f};
        pg8::gemm_phase<EpiResidT<true, false>, pg8::StaticOrder, true, true>(lds, g, S, E); }
#if (DUP_MASK >> 16) & 1
    for (int i_ = 0; i_ < 16; ++i_) SYNC();
#endif
#undef PH
#undef SYNC
}

extern "C" void kernel_launch(void* const* d_in, const int* in_sizes, int n_in, void* d_out, int out_size, void* d_ws, size_t ws_size, hipStream_t stream) {
    static int grid = 0;
    if (grid == 0) {
        if (n_in != 19 || out_size != MT * DM || ws_size < WS_END) { fprintf(stderr, "kernel_launch: unexpected shapes (n_in %d out %d ws %zu)\n", n_in, out_size, ws_size); grid = -1; return; }
        int dev = 0, cus = 0, per_cu = 0;
        hipGetDevice(&dev); hipDeviceGetAttribute(&cus, hipDeviceAttributeMultiprocessorCount, dev);
        if (hipFuncSetAttribute((const void*)mega, hipFuncAttributeMaxDynamicSharedMemorySize, LDS_BYTES) != hipSuccess) { fprintf(stderr, "kernel_launch: hipFuncSetAttribute failed\n"); grid = -1; return; }
        if (hipOccupancyMaxActiveBlocksPerMultiprocessor(&per_cu, (const void*)mega, 512, LDS_BYTES) != hipSuccess || per_cu < 1) { fprintf(stderr, "kernel_launch: occupancy query says %d\n", per_cu); per_cu = 1; }
        (void)hipGetLastError();
        grid = cus;
    }
    if (grid < 0) return;
    Params p{};
    p.x = (const float*)d_in[0]; p.c = (const float*)d_in[1]; p.pos = (const int*)d_in[2]; p.ada_w = (const float*)d_in[3]; p.ada_b = (const float*)d_in[4]; p.norm_g = (const float*)d_in[5];
    p.f1w1 = (const float*)d_in[6]; p.f1w3 = (const float*)d_in[7]; p.f1w2 = (const float*)d_in[8]; p.w_in = (const float*)d_in[9]; p.fbias = (const float*)d_in[10]; p.fox_g = (const float*)d_in[11];
    p.dsa_g = (const float*)d_in[12]; p.wbf = (const float*)d_in[13]; p.wbd = (const float*)d_in[14]; p.wout = (const float*)d_in[15]; p.f2w1 = (const float*)d_in[16]; p.f2w3 = (const float*)d_in[17]; p.f2w2 = (const float*)d_in[18];
    p.out = (float*)d_out; p.ws = (unsigned char*)d_ws;
    for (int i = 0; i < 8; ++i) p.invfA[i] = (float)pow(500000.0, -(double)(2 * i) / 16.0);
    for (int i = 0; i < 4; ++i) p.invfI[i] = (float)pow(500000.0, -(double)(2 * i) / 8.0);
    p.ph_lo = 0; p.ph_hi = 100;
    void* args[] = {&p};
    hipError_t e = hipLaunchCooperativeKernel((const void*)mega, dim3(grid), dim3(512), args, LDS_BYTES, stream);
    if (e != hipSuccess) fprintf(stderr, "kernel_launch: cooperative launch failed: %s (grid %d)\n", hipGetErrorString(e), grid);
}
```
